# Optimizing an MI355X kernel written in HIP

```python
import math
import jax, jax.numpy as jnp
from jax import lax
import numpy as np

D_MODEL = 1024
BATCH = 16
SEQ = 2048
DEPTH = 2

CHUNK = 64
Q_BLOCK = 128
EPS = 1e-6
A_HEADS = 4
A_QK_DIM = 32
A_V_DIM = 64
B_HEADS = 6
B_DIM = 64
CONV_WIDTH = 4
C_HEADS = 6
C_Q_LORA = 192
C_KV_LORA = 128
C_NOPE = 64
C_ROPE = 32
C_V_DIM = 64
ROPE_THETA = 10000.0
D_MIX = A_HEADS * A_V_DIM + B_HEADS * B_DIM + C_HEADS * C_V_DIM
IN_SIZES = (A_HEADS * A_QK_DIM, A_HEADS * A_QK_DIM, A_HEADS * A_QK_DIM, A_HEADS * A_QK_DIM, A_HEADS * A_V_DIM,
            B_HEADS * B_DIM, B_HEADS * B_DIM, B_HEADS * B_DIM, B_HEADS * B_DIM, B_HEADS, B_HEADS,
            C_Q_LORA, C_KV_LORA, C_ROPE)
IN_WIDTH = sum(IN_SIZES)
D_FF = 3584
N_EXPERTS = 8
TOP_K = 2
EXPERT_BLOCK = 256

kernel_name = "hybrid_hymba_diff_mlstm_mla_moe_block"


def rmsnorm(u, g):
    uf = u.astype(jnp.float32)
    r = uf * lax.rsqrt(jnp.mean(uf * uf, axis=-1, keepdims=True) + EPS)
    return (r * g.astype(jnp.float32)).astype(u.dtype)


def ada_modulation(c, w, b):
    p = jax.nn.silu(c) @ w + b
    shift, scale, gate = jnp.split(p, 3, axis=-1)
    return shift[:, None, :], scale[:, None, :], gate[:, None, :]


def chunk_mask(s0, s1):
    qc = (s0 + jnp.arange(s1 - s0)) // CHUNK
    kc = jnp.arange(s1) // CHUNK
    return kc[None, :] <= qc[:, None]


def masked_softmax(s, mask, scale):
    s = jnp.where(mask, s.astype(jnp.float32) * scale, -jnp.inf)
    return jax.nn.softmax(s, axis=-1)


def sweep_query_blocks(block_fn, seq):
    return jnp.concatenate([block_fn(s0, s0 + Q_BLOCK) for s0 in range(0, seq, Q_BLOCK)], axis=1)


def rope(u, cos, sin):
    half = u.shape[-1] // 2
    uf = u.astype(jnp.float32)
    u1, u2 = uf[..., :half], uf[..., half:]
    return jnp.concatenate([u1 * cos - u2 * sin, u1 * sin + u2 * cos], axis=-1).astype(u.dtype)


def causal_conv(u, w, b):
    k = w.shape[0]
    s = u.shape[1]
    up = jnp.pad(u, ((0, 0), (k - 1, 0), (0, 0)))
    return sum(up[:, j:j + s] * w[j] for j in range(k)) + b


def diff_attention_group(q1, q2, k1, k2, v, lam_q1, lam_k1, lam_q2, lam_k2, g_sub, lam_init):
    bsz, s, _ = q1.shape
    q1 = q1.reshape(bsz, s, A_HEADS, A_QK_DIM)
    q2 = q2.reshape(bsz, s, A_HEADS, A_QK_DIM)
    k1 = k1.reshape(bsz, s, A_HEADS, A_QK_DIM)
    k2 = k2.reshape(bsz, s, A_HEADS, A_QK_DIM)
    v = v.reshape(bsz, s, A_HEADS, A_V_DIM)
    f32 = jnp.float32
    lam = (jnp.exp(jnp.sum(lam_q1.astype(f32) * lam_k1.astype(f32)))
           - jnp.exp(jnp.sum(lam_q2.astype(f32) * lam_k2.astype(f32))) + lam_init)
    scale = A_QK_DIM ** -0.5

    def block(s0, s1):
        mask = chunk_mask(s0, s1)
        p1 = masked_softmax(jnp.einsum('bqhd,bkhd->bhqk', q1[:, s0:s1], k1[:, :s1]), mask, scale)
        p2 = masked_softmax(jnp.einsum('bqhd,bkhd->bhqk', q2[:, s0:s1], k2[:, :s1]), mask, scale)
        a = (p1 - lam * p2).astype(v.dtype)
        return jnp.einsum('bhqk,bkhd->bqhd', a, v[:, :s1])

    o = sweep_query_blocks(block, s)
    o = rmsnorm(o, g_sub) * (1.0 - lam_init)
    return o.reshape(bsz, s, A_HEADS * A_V_DIM)


def mlstm_group(q, k, v, o, ig_pre, fg_pre, w_conv, b_conv, b_i, b_f, g_out):
    bsz, s, _ = q.shape
    f32 = jnp.float32
    qk = jax.nn.silu(causal_conv(jnp.concatenate([q, k], axis=-1), w_conv, b_conv))
    q, k = jnp.split(qk, 2, axis=-1)
    nc = s // CHUNK

    def to_chunks(u):
        return u.astype(f32).reshape(bsz, nc, CHUNK, B_HEADS, B_DIM).transpose(1, 0, 3, 2, 4)

    def gate_chunks(g):
        return g.astype(f32).reshape(bsz, nc, CHUNK, B_HEADS).transpose(1, 0, 3, 2)

    qc, kc, vc = to_chunks(q), to_chunks(k) * (B_DIM ** -0.5), to_chunks(v)
    igc = gate_chunks(ig_pre.astype(f32) + b_i.astype(f32))
    lfc = jax.nn.log_sigmoid(gate_chunks(fg_pre.astype(f32) + b_f.astype(f32)))
    tril = jnp.tril(jnp.ones((CHUNK, CHUNK), dtype=bool))

    def step(carry, inp):
        cmat, nvec, m = carry
        qq, kk, vv, ig, lf = inp
        b = jnp.cumsum(lf, axis=-1)
        d = jnp.where(tril, b[..., :, None] - b[..., None, :] + ig[..., None, :], -jnp.inf)
        inter = b + m[..., None]
        m_t = jnp.maximum(inter, d.max(axis=-1))
        w_intra = jnp.exp(d - m_t[..., None])
        w_inter = jnp.exp(inter - m_t)
        sc = jnp.einsum('bhtd,bhsd->bhts', qq, kk) * w_intra
        num = jnp.einsum('bhts,bhsd->bhtd', sc, vv) + w_inter[..., None] * jnp.einsum('bhed,bhtd->bhte', cmat, qq)
        den = sc.sum(axis=-1) + w_inter * jnp.einsum('bhd,bhtd->bht', nvec, qq)
        h = num / jnp.maximum(jnp.abs(den), jnp.exp(-m_t))[..., None]
        b_last = b[..., -1]
        g = b_last[..., None] - b + ig
        m_new = jnp.maximum(b_last + m, g.max(axis=-1))
        w_s = jnp.exp(g - m_new[..., None])
        w_c = jnp.exp(b_last + m - m_new)
        cmat = w_c[..., None, None] * cmat + jnp.einsum('bhs,bhse,bhsd->bhed', w_s, vv, kk)
        nvec = w_c[..., None] * nvec + jnp.einsum('bhs,bhsd->bhd', w_s, kk)
        return (cmat, nvec, m_new), h

    init = (jnp.zeros((bsz, B_HEADS, B_DIM, B_DIM), f32), jnp.zeros((bsz, B_HEADS, B_DIM), f32),
            jnp.zeros((bsz, B_HEADS), f32))
    _, hc = lax.scan(step, init, (qc, kc, vc, igc, lfc))
    h = hc.transpose(1, 0, 3, 2, 4).reshape(bsz, s, B_HEADS, B_DIM)
    h = rmsnorm(h, g_out.reshape(B_HEADS, B_DIM)).reshape(bsz, s, B_HEADS * B_DIM)
    return h.astype(o.dtype) * jax.nn.sigmoid(o)


def mla_group(c_q, c_kv, k_rope, g_q_lat, g_kv_lat, w_uq, w_ukv, cos, sin):
    bsz, s, _ = c_q.shape
    q = (rmsnorm(c_q, g_q_lat) @ w_uq).reshape(bsz, s, C_HEADS, C_NOPE + C_ROPE)
    kv = (rmsnorm(c_kv, g_kv_lat) @ w_ukv).reshape(bsz, s, C_HEADS, C_NOPE + C_V_DIM)
    q_nope, q_rope = q[..., :C_NOPE], rope(q[..., C_NOPE:], cos[:, :, None, :], sin[:, :, None, :])
    k_nope, v = kv[..., :C_NOPE], kv[..., C_NOPE:]
    k_rope = rope(k_rope, cos, sin)
    scale = (C_NOPE + C_ROPE) ** -0.5

    def block(s0, s1):
        mask = chunk_mask(s0, s1)
        sc = (jnp.einsum('bqhd,bkhd->bhqk', q_nope[:, s0:s1], k_nope[:, :s1])
              + jnp.einsum('bqhr,bkr->bhqk', q_rope[:, s0:s1], k_rope[:, :s1]))
        p = masked_softmax(sc, mask, scale).astype(v.dtype)
        return jnp.einsum('bhqk,bkhd->bqhd', p, v[:, :s1])

    return sweep_query_blocks(block, s).reshape(bsz, s, C_HEADS * C_V_DIM)


def hybrid_mixer(h, positions, layer, w_in, w_out, lam_q1, lam_k1, lam_q2, lam_k2, g_diff,
                 w_conv, b_conv, b_igate, b_fgate, g_mlstm, g_q_lat, g_kv_lat, w_uq, w_ukv):
    split_idx = np.cumsum(IN_SIZES)[:-1].tolist()
    (q1, q2, k1, k2, va, qb, kb, vb, ob, ib, fb, cq, ckv, kr) = jnp.split(h @ w_in, split_idx, axis=-1)
    lam_init = 0.8 - 0.6 * math.exp(-0.3 * layer)
    out_a = diff_attention_group(q1, q2, k1, k2, va, lam_q1, lam_k1, lam_q2, lam_k2, g_diff, lam_init)
    out_b = mlstm_group(qb, kb, vb, ob, ib, fb, w_conv, b_conv, b_igate, b_fgate, g_mlstm)
    freqs = ROPE_THETA ** (-jnp.arange(0, C_ROPE, 2, dtype=jnp.float32) / C_ROPE)
    ang = positions.astype(jnp.float32)[..., None] * freqs
    out_c = mla_group(cq, ckv, kr, g_q_lat, g_kv_lat, w_uq, w_ukv, jnp.cos(ang), jnp.sin(ang))
    return jnp.concatenate([out_a, out_b, out_c], axis=-1) @ w_out


def swiglu(u, wg, wu, wd):
    return (jax.nn.silu(u @ wg) * (u @ wu)) @ wd


def moe_swiglu(h, w_router, b_router, w_gate_e, w_up_e, w_down_e):
    bsz, s, d = h.shape
    n = bsz * s
    t = h.reshape(n, d)
    logits = (t @ w_router).astype(jnp.float32) + b_router.astype(jnp.float32)
    top_val, top_idx = lax.top_k(logits, TOP_K)
    gates = jax.nn.softmax(top_val, axis=-1)
    e_flat = top_idx.reshape(-1)
    tok_flat = jnp.repeat(jnp.arange(n, dtype=jnp.int32), TOP_K)
    g_flat = gates.reshape(-1)
    order = jnp.argsort(e_flat, stable=True)
    e_sorted, tok_sorted, g_sorted = e_flat[order], tok_flat[order], g_flat[order]
    counts = jnp.zeros((N_EXPERTS,), jnp.int32).at[e_flat].add(1)
    starts = jnp.cumsum(counts) - counts
    padded = ((counts + EXPERT_BLOCK - 1) // EXPERT_BLOCK) * EXPERT_BLOCK
    pend = jnp.cumsum(padded)
    pstarts = pend - padded
    dest = pstarts[e_sorted] + (jnp.arange(n * TOP_K, dtype=jnp.int32) - starts[e_sorted])
    n_blocks = -(-(n * TOP_K) // EXPERT_BLOCK) + N_EXPERTS
    p = n_blocks * EXPERT_BLOCK
    buf_tok = jnp.full((p,), n, jnp.int32).at[dest].set(tok_sorted)
    t_pad = jnp.concatenate([t, jnp.zeros((1, d), t.dtype)], axis=0)
    xb = t_pad[buf_tok].reshape(n_blocks, EXPERT_BLOCK, d)
    blk_e = jnp.minimum(jnp.searchsorted(pend, jnp.arange(n_blocks) * EXPERT_BLOCK, side='right'), N_EXPERTS - 1)

    def expert_block(args):
        xblk, e = args
        return swiglu(xblk, w_gate_e[e], w_up_e[e], w_down_e[e])

    yb = lax.map(expert_block, (xb, blk_e)).reshape(p, d)
    y = jnp.zeros((n, d), h.dtype).at[tok_sorted].add(yb[dest] * g_sorted[:, None].astype(h.dtype))
    return y.reshape(bsz, s, d)


def setup_inputs(seed: int = 0) -> dict:
    key = jax.random.key(seed)
    ks = jax.random.split(key, 32)
    f32 = jnp.float32
    n_dense = (DEPTH + 1) // 2
    n_moe = DEPTH // 2

    def nrm(k, shape, scale):
        return jax.random.normal(k, shape, f32) * scale

    def gain(k, shape):
        return 1.0 + 0.05 * jax.random.normal(k, shape, f32)

    offsets = jax.random.randint(ks[2], (BATCH, 1), 0, 64, dtype=jnp.int32) * CHUNK
    positions = offsets + jnp.arange(SEQ, dtype=jnp.int32)[None, :]
    b_fgate = jnp.linspace(3.0, 6.0, B_HEADS, dtype=f32)[None, :] + 0.1 * jax.random.normal(ks[15], (DEPTH, B_HEADS), f32)
    return {
        "x": nrm(ks[0], (BATCH, SEQ, D_MODEL), 1.0),
        "c": nrm(ks[1], (BATCH, D_MODEL), 1.0),
        "positions": positions,
        "w_ada": nrm(ks[3], (DEPTH, 2, D_MODEL, 3 * D_MODEL), D_MODEL ** -0.5),
        "b_ada": nrm(ks[4], (DEPTH, 2, 3 * D_MODEL), 0.01),
        "g_norm": gain(ks[5], (DEPTH, 4, D_MODEL)),
        "w_in": nrm(ks[6], (DEPTH, D_MODEL, IN_WIDTH), D_MODEL ** -0.5),
        "w_out": nrm(ks[7], (DEPTH, D_MIX, D_MODEL), D_MIX ** -0.5),
        "lam_q1": nrm(ks[8], (DEPTH, A_QK_DIM), 0.1),
        "lam_k1": nrm(ks[9], (DEPTH, A_QK_DIM), 0.1),
        "lam_q2": nrm(ks[10], (DEPTH, A_QK_DIM), 0.1),
        "lam_k2": nrm(ks[11], (DEPTH, A_QK_DIM), 0.1),
        "g_diff": gain(ks[12], (DEPTH, A_V_DIM)),
        "w_conv": nrm(ks[13], (DEPTH, CONV_WIDTH, 2 * B_HEADS * B_DIM), CONV_WIDTH ** -0.5),
        "b_conv": nrm(ks[14], (DEPTH, 2 * B_HEADS * B_DIM), 0.01),
        "b_igate": nrm(ks[16], (DEPTH, B_HEADS), 0.1),
        "b_fgate": b_fgate,
        "g_mlstm": gain(ks[17], (DEPTH, B_HEADS * B_DIM)),
        "g_q_lat": gain(ks[18], (DEPTH, C_Q_LORA)),
        "g_kv_lat": gain(ks[19], (DEPTH, C_KV_LORA)),
        "w_uq": nrm(ks[20], (DEPTH, C_Q_LORA, C_HEADS * (C_NOPE + C_ROPE)), C_Q_LORA ** -0.5),
        "w_ukv": nrm(ks[21], (DEPTH, C_KV_LORA, C_HEADS * (C_NOPE + C_V_DIM)), C_KV_LORA ** -0.5),
        "w_gate_d": nrm(ks[22], (n_dense, D_MODEL, D_FF), D_MODEL ** -0.5),
        "w_up_d": nrm(ks[23], (n_dense, D_MODEL, D_FF), D_MODEL ** -0.5),
        "w_down_d": nrm(ks[24], (n_dense, D_FF, D_MODEL), D_FF ** -0.5),
        "w_router": nrm(ks[25], (n_moe, D_MODEL, N_EXPERTS), D_MODEL ** -0.5),
        "b_router": nrm(ks[26], (n_moe, N_EXPERTS), 0.01),
        "w_gate_e": nrm(ks[27], (n_moe, N_EXPERTS, D_MODEL, D_FF), D_MODEL ** -0.5),
        "w_up_e": nrm(ks[28], (n_moe, N_EXPERTS, D_MODEL, D_FF), D_MODEL ** -0.5),
        "w_down_e": nrm(ks[29], (n_moe, N_EXPERTS, D_FF, D_MODEL), D_FF ** -0.5),
    }


def reference(x, c, positions, w_ada, b_ada, g_norm, w_in, w_out, lam_q1, lam_k1, lam_q2, lam_k2, g_diff,
              w_conv, b_conv, b_igate, b_fgate, g_mlstm, g_q_lat, g_kv_lat, w_uq, w_ukv,
              w_gate_d, w_up_d, w_down_d, w_router, b_router, w_gate_e, w_up_e, w_down_e):
    for l in range(DEPTH):
        shift, scale, gate = ada_modulation(c, w_ada[l, 0], b_ada[l, 0])
        h = rmsnorm(x, g_norm[l, 0]) * (1.0 + scale) + shift
        y = hybrid_mixer(h, positions, l, w_in[l], w_out[l], lam_q1[l], lam_k1[l], lam_q2[l], lam_k2[l], g_diff[l],
                         w_conv[l], b_conv[l], b_igate[l], b_fgate[l], g_mlstm[l], g_q_lat[l], g_kv_lat[l],
                         w_uq[l], w_ukv[l])
        x = x + gate * rmsnorm(y, g_norm[l, 1])
        shift, scale, gate = ada_modulation(c, w_ada[l, 1], b_ada[l, 1])
        h = rmsnorm(x, g_norm[l, 2]) * (1.0 + scale) + shift
        if l % 2 == 0:
            y = swiglu(h, w_gate_d[l // 2], w_up_d[l // 2], w_down_d[l // 2])
        else:
            y = moe_swiglu(h, w_router[l // 2], b_router[l // 2], w_gate_e[l // 2], w_up_e[l // 2], w_down_e[l // 2])
        x = x + gate * rmsnorm(y, g_norm[l, 3])
    return x
```

```cpp
#include <hip/hip_runtime.h>
#include <cstdio>
#include <cstdint>

#ifndef MK_SINGLE
#ifndef ATT_FUSED
#define ATT_FUSED 1
#endif
#ifndef ATT_CINIT
#define ATT_CINIT 1
#endif
#define MLA_QSCALE_ON (ATT_FUSED && ATT_CINIT)
#define ATT_CINIT 0
#define MK_SINGLE 1
#endif

#define GAS __attribute__((address_space(1)))
#define LAS __attribute__((address_space(3)))
#define DI __device__ __forceinline__
typedef unsigned short bf16;
typedef short bf16x8 __attribute__((ext_vector_type(8)));
typedef short s16x4 __attribute__((ext_vector_type(4)));
typedef float f32x2 __attribute__((ext_vector_type(2)));
typedef float f32x4 __attribute__((ext_vector_type(4)));
typedef float f32x16 __attribute__((ext_vector_type(16)));
typedef unsigned u32x2 __attribute__((ext_vector_type(2)));
typedef unsigned u32x4 __attribute__((ext_vector_type(4)));
typedef int i32x8 __attribute__((ext_vector_type(8)));
typedef short s16x16 __attribute__((ext_vector_type(16)));
typedef __bf16 bf16x2_t __attribute__((ext_vector_type(2)));
typedef GAS unsigned gu32;

constexpr int D = 1024, BATCH = 16, SEQ = 2048, NTOK = BATCH * SEQ, DEPTH = 2;
constexpr int INW = 2668, DFF = 3584, NEXP = 8;
constexpr float EPS = 1e-6f;
constexpr int NWAVES = 8, NTHR = 512;
constexpr float LOG2E = 1.4426950408889634f;
constexpr float MLA_QSCALE = MLA_QSCALE_ON ? 0.10206207261596577f * 1.4426950408889634f : 1.f;

constexpr size_t MiB = 1u << 20;
constexpr size_t WS_CTL = 0, CTL_ZERO_BYTES = 32768;
constexpr size_t WS_MOD = 1 * MiB;
constexpr size_t WS_CS = 2 * MiB;
constexpr size_t WS_BT2 = 6 * MiB;
constexpr size_t WS_A2 = WS_BT2 + 768 * 1024;
constexpr size_t WS_GATE = 7 * MiB + 768 * 1024;
constexpr size_t WS_LIST = 8 * MiB;
constexpr size_t WS_WIN = 9 * MiB;
constexpr size_t WS_WV = WS_WIN + 8 * MiB;
constexpr size_t WS_WOUT = WS_WV + 3 * MiB;
constexpr size_t WS_WUQ = WS_WOUT + 4 * MiB;
constexpr size_t WS_WUKK = WS_WUQ + 768 * 1024;
constexpr size_t WS_WUKV = WS_WUKK + 256 * 1024;
constexpr size_t WS_WGUD = WS_WUKV + 256 * 1024;
constexpr size_t WS_WDD = WS_WGUD + 14 * MiB;
constexpr size_t WS_WGUE = WS_WDD + 7 * MiB;
constexpr size_t WS_WDE = WS_WGUE + 56 * MiB;
constexpr size_t WS_XB = WS_WDE + 28 * MiB;
constexpr size_t WS_DC = WS_XB + 64 * MiB;
constexpr size_t WS_DN = WS_DC + 10752 * 1024;
constexpr size_t WS_ACT0 = 215 * MiB;
static_assert(WS_DN + 172032 <= WS_ACT0, "weights");
constexpr size_t WS_HB = WS_ACT0;
constexpr size_t WS_CQN = WS_HB;
constexpr size_t WS_CKVN = WS_HB + 16 * MiB;
constexpr size_t WS_P1 = WS_HB + 64 * MiB;
constexpr size_t WS_P2 = WS_P1 + 64 * MiB;
constexpr size_t WS_VTC = WS_P2;
constexpr size_t WS_Y = WS_P1;
constexpr size_t WS_VTAB = WS_P2 + 64 * MiB;
constexpr size_t WS_QBC = WS_VTAB + 40 * MiB;
constexpr size_t WS_KBC = WS_QBC + 24 * MiB;
constexpr size_t WS_QC = WS_KBC + 24 * MiB;
constexpr size_t WS_KC = WS_QC + 36 * MiB;
constexpr size_t WS_END = WS_KC + 36 * MiB;
constexpr size_t WS_ACT = WS_P1;
#ifndef DENSE_FP8
#define DENSE_FP8 2
#endif
constexpr size_t WS_Y2 = WS_ACT + (DENSE_FP8 == 1 ? 112 : 224) * MiB;
constexpr size_t WS_YM = WS_ACT + 112 * MiB;
constexpr size_t WS_H8 = WS_YM + 128 * MiB;
static_assert(WS_Y2 + 64 * MiB <= WS_END && WS_H8 + 32 * MiB <= WS_END && (DENSE_FP8 != 1 || WS_Y2 + 64 * MiB <= WS_H8), "ffn overlay");
static_assert(WS_END <= 594600000ull, "workspace");
constexpr int CW_BAR = 4096;
constexpr int CW_ATTQ = 64;
constexpr int CW_MOECNT = 256;
constexpr int MOE_CHUNK_TILES = 128, MOE_MAX_CHUNKS = 3;

constexpr int RING_BYTES = 131072;
constexpr int MISC_OFF = RING_BYTES;
constexpr int LDS_BYTES = 147456;

DI unsigned cvtpk(float lo, float hi) { f32x2 v = {lo, hi}; bf16x2_t b = __builtin_convertvector(v, bf16x2_t); return __builtin_bit_cast(unsigned, b); }
DI unsigned pk4_fp8(float a, float b, float c, float d) { int p = __builtin_amdgcn_cvt_pk_fp8_f32(a, b, 0, false); p = __builtin_amdgcn_cvt_pk_fp8_f32(c, d, p, true); return (unsigned)p; }
DI float bf2f(unsigned short b) { return __builtin_bit_cast(float, (unsigned)b << 16); }
DI float bflo(unsigned w) { return __builtin_bit_cast(float, w << 16); }
DI float bfhi(unsigned w) { return __builtin_bit_cast(float, w & 0xffff0000u); }
DI float lane_read(float v, int src_lane) { return __builtin_bit_cast(float, __builtin_amdgcn_ds_bpermute(src_lane << 2, __builtin_bit_cast(int, v))); }
DI float wave_sum(float v, int lane) {
#pragma unroll
    for (int o = 1; o < 64; o <<= 1) v += lane_read(v, lane ^ o);
    return v;
}
DI void wave_sum2(float& a, float& b, int lane) {
#pragma unroll
    for (int o = 1; o < 64; o <<= 1) { const float ta = lane_read(a, lane ^ o), tb = lane_read(b, lane ^ o); a += ta; b += tb; }
}
DI float half_swap_sum(float v) { auto rr = __builtin_amdgcn_permlane32_swap(__float_as_uint(v), __float_as_uint(v), false, false); return __uint_as_float(rr[0]) + __uint_as_float(rr[1]); }
DI float half_swap_max(float v) { auto rr = __builtin_amdgcn_permlane32_swap(__float_as_uint(v), __float_as_uint(v), false, false); return fmaxf(__uint_as_float(rr[0]), __uint_as_float(rr[1])); }
DI float siluf(float x) { return x * __builtin_amdgcn_rcpf(1.f + __builtin_amdgcn_exp2f(x * -1.4426950408889634f)); }
DI float sigmoidf_(float x) { return __builtin_amdgcn_rcpf(1.f + __builtin_amdgcn_exp2f(x * -1.4426950408889634f)); }
#define LDS_WAIT() asm volatile("s_waitcnt lgkmcnt(0)" ::: "memory")
#define VM_WAIT() asm volatile("s_waitcnt vmcnt(0)" ::: "memory")

#define XB_TMO      128
#define XB_XCNT(j)  (256  + 64 * (j))
#define XB_XSUB(j)  (1280 + 64 * (j))
#define XB_XGEN(j)  (2304 + 64 * (j))
#define XB_TOP      3328
#define XB_TOPGEN   3392
#define XCD_BAR_WORDS 3456
#define XB_SPIN_CAP (1u << 22)
DI unsigned xb_ld(unsigned* p)              { return __hip_atomic_load(p, __ATOMIC_RELAXED, __HIP_MEMORY_SCOPE_AGENT); }
DI unsigned xb_add(unsigned* p, unsigned v) { return __hip_atomic_fetch_add(p, v, __ATOMIC_RELAXED, __HIP_MEMORY_SCOPE_AGENT); }
DI unsigned xb_xcc_id() { return (unsigned)__builtin_amdgcn_s_getreg((3 << 11) | 20) & 0xFu; }
#define XB_SPIN(cond, bar) do { unsigned _sp = 0; while (cond) { __builtin_amdgcn_s_sleep(1); \
    if ((++_sp & 255u) == 0u) { if (xb_ld(&(bar)[XB_TMO])) break; if (_sp > XB_SPIN_CAP) { atomicAdd(&(bar)[XB_TMO], 1u); break; } } } } while (0)
struct XcdBarrier { unsigned* bar; unsigned x; volatile LAS unsigned* st; };
DI XcdBarrier xcd_barrier_post(unsigned* bar, volatile LAS unsigned* st, bool leader) {
    XcdBarrier b; b.bar = bar; b.x = xb_xcc_id(); b.st = st;
    if (leader) (void)xb_add(&bar[XB_XCNT(b.x)], 1u);
    return b;
}
DI void xcd_barrier_complete(unsigned* bar, unsigned x, unsigned& nloc, unsigned& nx) {
    const unsigned G = gridDim.x * gridDim.y * gridDim.z;
    unsigned sum, cnt, mine, sp = 0u;
    for (;;) {
        sum = 0u; cnt = 0u; mine = 0u;
#pragma unroll
        for (unsigned j = 0; j < 16; ++j) { const unsigned c = xb_ld(&bar[XB_XCNT(j)]); sum += c; cnt += (c > 0u) ? 1u : 0u; mine = (j == x) ? c : mine; }
        if (sum == G) break;
        __builtin_amdgcn_s_sleep(1);
        if ((++sp & 255u) == 0u) { if (xb_ld(&bar[XB_TMO])) break; if (sp > XB_SPIN_CAP) { atomicAdd(&bar[XB_TMO], 1u); break; } }
    }
    nloc = mine > 0u ? mine : 1u; nx = cnt > 0u ? cnt : 1u;
}
DI void xcd_barrier(const XcdBarrier& b, int wave_id) {
    int ln_; asm volatile("v_mbcnt_lo_u32_b32 %0, -1, 0\n\tv_mbcnt_hi_u32_b32 %0, -1, %0" : "=v"(ln_)); const bool leader = (wave_id == 0) && (ln_ == 0);
    asm volatile("s_waitcnt vmcnt(0)" ::: "memory");
    __syncthreads();
    if (leader) {
        unsigned* bar = b.bar;
        __builtin_amdgcn_s_waitcnt(0);
        unsigned nloc = b.st[0], nx = b.st[1];
        if (nloc == 0u) { xcd_barrier_complete(bar, b.x, nloc, nx); b.st[0] = nloc; b.st[1] = nx; }
        const unsigned old = xb_add(&bar[XB_XSUB(b.x)], 1u);
        const unsigned gen = old / nloc;
        if (old + 1u == (gen + 1u) * nloc) {
            __builtin_amdgcn_fence(__ATOMIC_RELEASE, "agent");
            asm volatile("s_waitcnt vmcnt(0)" ::: "memory");
            const unsigned og = xb_add(&bar[XB_TOP], 1u);
            const unsigned tg = og / nx;
            if (og + 1u == (tg + 1u) * nx) xb_add(&bar[XB_TOPGEN], 1u);
            else XB_SPIN(xb_ld(&bar[XB_TOPGEN]) == tg, bar);
            __builtin_amdgcn_fence(__ATOMIC_ACQUIRE, "agent");
            xb_add(&bar[XB_XGEN(b.x)], 1u);
            asm volatile("s_waitcnt vmcnt(0)" ::: "memory");
        } else {
            XB_SPIN(xb_ld(&bar[XB_XGEN(b.x)]) == gen, bar);
            __builtin_amdgcn_fence(__ATOMIC_ACQUIRE, "agent");
            asm volatile("s_waitcnt vmcnt(0)" ::: "memory");
        }
    }
    __syncthreads();
}

namespace pg8 {
constexpr int BM = 256, BK = 64, HALF = 128, HTB = HALF * BK * 2, STAGE_BYTES = 8 * HTB, NXCD = 8, WGM = 8;
__host__ __device__ __forceinline__ int lds_byte(int r, int c) { const int st = (r >> 4) * 2 + (c >> 5), rr = r & 15, cc = c & 31, ob = rr * 64 + cc * 2; return st * 1024 + (ob ^ (((ob >> 9) & 1) << 5)); }
__host__ __device__ __forceinline__ void stage_rc(int b, int& R, int& C) { const int st = b / 1024, sb = b % 1024, swz = sb ^ (((sb >> 9) & 1) << 5); R = (st >> 1) * 16 + swz / 64; C = (st & 1) * 32 + (swz % 64) / 2; }
__host__ __device__ __forceinline__ int perm32(int rho) { const int n = rho >> 4, i = rho & 15; return 8 * (i >> 2) + 4 * n + (i & 3); }

struct Unit { int pm, pn; int arow; int brow; int lidx; int nvalid; };
enum { EPI_STORE = 0, EPI_ROPEQ = 1, EPI_KNOPE = 2, EPI_SWIGLU = 3, EPI_SCATTER = 4, EPI_SWIGLU8 = 5 };
enum { SCH_STATIC = 0, SCH_MOE = 1 };
struct Job {
    const bf16* A; const bf16* Bt; int lda, ldb, K;
    int nM, nN;
    int sched, rot;
    int epi;
    bf16* O; int ldc; int row_limit; int split_cols; long split_stride;
    const float* cs;
    const int* glist;
    int gather;
    int tile0;
    int bexp_rows;
};
struct MoeMeta { int pref[9]; int cnt[8]; };

template <bool MOE> DI bool sched_next(const Job& J, const LAS int* mm  , int i, int G, int c, Unit& u) {
    const int nwg = J.nM * J.nN;
    const long L = (long)i * G + ((c + J.rot) % G); if (L >= nwg) return false;
    int wgid = (int)L; { const int q = nwg / NXCD, r = nwg % NXCD, xcd = wgid % NXCD, off = wgid / NXCD; wgid = (xcd < r ? xcd * (q + 1) : r * (q + 1) + (xcd - r) * q) + off; }
    const int nig = WGM * J.nN, gid = wgid / nig, fm = gid * WGM, gsz = (J.nM - fm) < WGM ? (J.nM - fm) : WGM;
    u.pm = fm + ((wgid % nig) % gsz); u.pn = (wgid % nig) / gsz;
    u.arow = u.pm * BM; u.brow = u.pn * BM; u.lidx = 0; u.nvalid = BM;
    if constexpr (MOE) {
        const int tg = J.tile0 + u.pm; int e = 0;
#pragma unroll
        for (int k = 1; k < 8; ++k) e += (tg >= mm[k]) ? 1 : 0;
        const int t = tg - mm[e];
        u.lidx = e * 32768 + t * 256; const int rem = mm[9 + e] - t * 256; u.nvalid = rem < 256 ? rem : 256;
        u.brow = e * J.bexp_rows + u.pn * BM;
    }
    return true;
}

template <int EPI> DI void epilogue(const Job& J, const f32x4 (&acc)[2][2][4][2], const Unit& u, int wr, int wc, int fr_, int fq_) {
    int ln_; asm volatile("v_mbcnt_lo_u32_b32 %0, -1, 0\n\tv_mbcnt_hi_u32_b32 %0, -1, %0" : "=v"(ln_));
    const int fr = ln_ & 15, fq = ln_ >> 4; (void)fr_; (void)fq_;
    const int rloc0 = wr * 64 + fr;
    const int cloc0 = wc * 32 + 8 * fq;
    if constexpr (EPI == EPI_STORE) {
        int colt = u.pn * BM; bf16* base = J.O;
        if (J.split_cols) { const int t = colt / J.split_cols; base += (long)t * J.split_stride; colt -= t * J.split_cols; }
#pragma unroll
        for (int ai = 0; ai < 2; ++ai)
#pragma unroll
            for (int m = 0; m < 4; ++m) { const int row = u.pm * BM + rloc0 + ai * HALF + m * 16;
                if (row < J.row_limit) { bf16* rowp = base + (size_t)row * J.ldc + colt + cloc0;
#pragma unroll
                    for (int bj = 0; bj < 2; ++bj) { const f32x4 v0 = acc[ai][bj][m][0], v1 = acc[ai][bj][m][1]; u32x4 w; w.x = cvtpk(v0[0], v0[1]); w.y = cvtpk(v0[2], v0[3]); w.z = cvtpk(v1[0], v1[1]); w.w = cvtpk(v1[2], v1[3]);
                        *(u32x4*)(rowp + bj * HALF) = w; } } }
    } else if constexpr (EPI == EPI_ROPEQ) {
#pragma unroll
        for (int bj = 0; bj < 2; ++bj) { const int col = u.pn * BM + bj * HALF + cloc0;
            if (col < 576) { const int d = col % 96; const bool rp = d >= 64; const int g4 = rp ? (d - 64) >> 1 : 0;
                f32x4 csv[2][4], snv[2][4];
#pragma unroll
                for (int ai = 0; ai < 2; ++ai)
#pragma unroll
                    for (int m = 0; m < 4; ++m) { const int row = u.pm * BM + rloc0 + ai * HALF + m * 16; csv[ai][m] = *(const f32x4*)(J.cs + (size_t)row * 32 + g4); snv[ai][m] = *(const f32x4*)(J.cs + (size_t)row * 32 + 16 + g4); }
#pragma unroll
                for (int ai = 0; ai < 2; ++ai)
#pragma unroll
                    for (int m = 0; m < 4; ++m) { const int row = u.pm * BM + rloc0 + ai * HALF + m * 16; f32x4 v0 = acc[ai][bj][m][0], v1 = acc[ai][bj][m][1];
                        if (rp) { const f32x4 cs = csv[ai][m], sn = snv[ai][m];
                            const f32x4 o1 = v0 * cs - v1 * sn, o2 = v0 * sn + v1 * cs; v0 = o1; v1 = o2; }
                        v0 *= MLA_QSCALE; v1 *= MLA_QSCALE;
                        u32x4 w; w.x = cvtpk(v0[0], v0[1]); w.y = cvtpk(v0[2], v0[3]); w.z = cvtpk(v1[0], v1[1]); w.w = cvtpk(v1[2], v1[3]);
                        *(u32x4*)(J.O + (size_t)row * 576 + col) = w; } } }
    } else if constexpr (EPI == EPI_KNOPE) {
#pragma unroll
        for (int bj = 0; bj < 2; ++bj) { const int col = u.pn * BM + bj * HALF + cloc0;
            if (col < 384) { const int oc = (col >> 6) * 96 + (col & 63);
#pragma unroll
                for (int ai = 0; ai < 2; ++ai)
#pragma unroll
                    for (int m = 0; m < 4; ++m) { const int row = u.pm * BM + rloc0 + ai * HALF + m * 16; const f32x4 v0 = acc[ai][bj][m][0], v1 = acc[ai][bj][m][1];
                        u32x4 w; w.x = cvtpk(v0[0], v0[1]); w.y = cvtpk(v0[2], v0[3]); w.z = cvtpk(v1[0], v1[1]); w.w = cvtpk(v1[2], v1[3]);
                        *(u32x4*)(J.O + (size_t)row * 576 + oc) = w; } } }
    } else if constexpr (EPI == EPI_SWIGLU) {
#pragma unroll
        for (int ai = 0; ai < 2; ++ai)
#pragma unroll
            for (int m = 0; m < 4; ++m) { const int row = u.pm * BM + rloc0 + ai * HALF + m * 16; u32x4 w; float o[8];
#pragma unroll
                for (int n = 0; n < 2; ++n)
#pragma unroll
                    for (int q = 0; q < 4; q += 2) {
                        const f32x2 g2 = {acc[ai][0][m][n][q], acc[ai][0][m][n][q + 1]}, u2 = {acc[ai][1][m][n][q], acc[ai][1][m][n][q + 1]};
                        f32x2 d2 = {__builtin_amdgcn_exp2f(g2.x), __builtin_amdgcn_exp2f(g2.y)}; d2 += (f32x2){1.f, 1.f};
                        const f32x2 r2 = {__builtin_amdgcn_rcpf(d2.x), __builtin_amdgcn_rcpf(d2.y)}, o2 = (g2 * u2) * r2; o[n * 4 + q] = o2.x; o[n * 4 + q + 1] = o2.y; }
                w.x = cvtpk(o[0], o[1]); w.y = cvtpk(o[2], o[3]); w.z = cvtpk(o[4], o[5]); w.w = cvtpk(o[6], o[7]);
                *(u32x4*)(J.O + (size_t)row * J.ldc + u.pn * HALF + cloc0) = w; }
    } else if constexpr (EPI == EPI_SWIGLU8) {
#pragma unroll
        for (int ai = 0; ai < 2; ++ai)
#pragma unroll
            for (int m = 0; m < 4; ++m) { const int row = u.pm * BM + rloc0 + ai * HALF + m * 16; float o[8];
#pragma unroll
                for (int n = 0; n < 2; ++n)
#pragma unroll
                    for (int q = 0; q < 4; q += 2) {
                        const f32x2 g2 = {acc[ai][0][m][n][q], acc[ai][0][m][n][q + 1]}, u2 = {acc[ai][1][m][n][q], acc[ai][1][m][n][q + 1]};
                        f32x2 d2 = {__builtin_amdgcn_exp2f(g2.x), __builtin_amdgcn_exp2f(g2.y)}; d2 += (f32x2){1.f, 1.f};
                        const f32x2 r2 = {__builtin_amdgcn_rcpf(d2.x), __builtin_amdgcn_rcpf(d2.y)}, o2 = (g2 * u2) * r2; o[n * 4 + q] = o2.x; o[n * 4 + q + 1] = o2.y; }
                u32x2 w; w.x = pk4_fp8(o[0], o[1], o[2], o[3]); w.y = pk4_fp8(o[4], o[5], o[6], o[7]);
                *(u32x2*)((unsigned char*)J.O + (size_t)row * J.ldc + u.pn * HALF + cloc0) = w; }
    } else {
        int slots[2][4];
#pragma unroll
        for (int ai = 0; ai < 2; ++ai)
#pragma unroll
            for (int m = 0; m < 4; ++m) { const int rl = rloc0 + ai * HALF + m * 16; slots[ai][m] = J.glist[u.lidx + (rl < u.nvalid ? rl : u.nvalid - 1)]; }
#pragma unroll
        for (int ai = 0; ai < 2; ++ai)
#pragma unroll
            for (int m = 0; m < 4; ++m) { const int rl = rloc0 + ai * HALF + m * 16;
                bf16* rowp = (rl < u.nvalid) ? J.O + (size_t)slots[ai][m] * J.ldc + u.pn * BM + cloc0 : (bf16*)J.cs + cloc0;
#pragma unroll
                for (int bj = 0; bj < 2; ++bj) { const f32x4 v0 = acc[ai][bj][m][0], v1 = acc[ai][bj][m][1]; u32x4 w; w.x = cvtpk(v0[0], v0[1]); w.y = cvtpk(v0[2], v0[3]); w.z = cvtpk(v1[0], v1[1]); w.w = cvtpk(v1[2], v1[3]);
                    *(u32x4*)(rowp + bj * HALF) = w; } }
    }
}

template <int EPI, bool MOE, bool FP8 = false> DI void gemm_phase(LAS unsigned char* lds, const LAS int* mm, const Job& J, int G, int cu, int wave_id) {
    constexpr bool GATHER = MOE && (EPI == EPI_SWIGLU || EPI == EPI_SWIGLU8);
    constexpr int ESZ = FP8 ? 1 : 2;
    int tid; asm volatile("v_mbcnt_lo_u32_b32 %0, -1, 0\n\tv_mbcnt_hi_u32_b32 %0, -1, %0" : "=v"(tid)); tid += wave_id * 64;
    const int wid = __builtin_amdgcn_readfirstlane(tid >> 6), lane = tid & 63, wr = wid >> 2, wc = wid & 3, fr = lane & 15, fq = lane >> 4;
    const int K = J.K, nt = K * ESZ / 128;
    unsigned voffB[2];
#pragma unroll
    for (int i = 0; i < 2; ++i) { int R, C; stage_rc(tid * 16 + i * 8192, R, C); const int Rb = (R & ~31) + perm32(R & 31); voffB[i] = (unsigned)(Rb * J.ldb * ESZ + C * 2); }
    const size_t kstep = (size_t)(BK * 2);
    const size_t hstepB = (size_t)HALF * J.ldb * ESZ;
    const unsigned ldsw = (unsigned)wid * 1024u;
    const int aoff = lds_byte(wr * 64 + fr, fq * (FP8 ? 16 : 8)), boff = lds_byte(wc * 32 + fr, fq * (FP8 ? 16 : 8));
    constexpr int KOFF = FP8 ? 16 : 1024;
#define PG8_SA(b, h) (((b) * 2 + (h)) * HTB)
#define PG8_SB(b, h) ((4 + (b) * 2 + (h)) * HTB)
#define PG8_STAGE_B(bufoff, gbase) do { _Pragma("unroll") for (int _i = 0; _i < 2; ++_i) \
        __builtin_amdgcn_global_load_lds((const unsigned*)((const char*)(gbase) + voffB[_i]), (LAS unsigned*)(lds + (bufoff) + ldsw + _i * 8192), 16, 0, 0); } while (0)
#define PG8_STAGE_A(bufoff, kbyte, O0, O1) do { \
        __builtin_amdgcn_global_load_lds((const unsigned*)((const char*)J.A + (kbyte) + (O0)), (LAS unsigned*)(lds + (bufoff) + ldsw), 16, 0, 0); \
        __builtin_amdgcn_global_load_lds((const unsigned*)((const char*)J.A + (kbyte) + (O1)), (LAS unsigned*)(lds + (bufoff) + ldsw + 8192), 16, 0, 0); } while (0)
#define PG8_LD8(dst, addr) do { const u32x4 lo_ = *(const LAS u32x4*)(addr), hi_ = *(const LAS u32x4*)((addr) + KOFF); \
        dst = (i32x8){(int)lo_.x, (int)lo_.y, (int)lo_.z, (int)lo_.w, (int)hi_.x, (int)hi_.y, (int)hi_.z, (int)hi_.w}; } while (0)
#define PG8_LDA(dst, b, h) do { _Pragma("unroll") for (int m = 0; m < 4; ++m) PG8_LD8(dst[m], lds + PG8_SA(b, h) + aoff + m * 2048); } while (0)
#define PG8_LDB(dst, b, h) do { _Pragma("unroll") for (int n = 0; n < 2; ++n) PG8_LD8(dst[n], lds + PG8_SB(b, h) + boff + n * 2048); } while (0)
#define PG8_LO(v) __builtin_bit_cast(bf16x8, __builtin_shufflevector(v, v, 0, 1, 2, 3))
#define PG8_HI(v) __builtin_bit_cast(bf16x8, __builtin_shufflevector(v, v, 4, 5, 6, 7))
#define PG8_MMA(ai, bj, At, Bt) do { __builtin_amdgcn_s_setprio(1); _Pragma("unroll") for (int m = 0; m < 4; ++m) _Pragma("unroll") for (int n = 0; n < 2; ++n) { \
        if constexpr (FP8) asm volatile("v_mfma_scale_f32_16x16x128_f8f6f4 %0, %1, %2, %0, %3, %4 op_sel_hi:[0,0,0]" : "+v"(acc[ai][bj][m][n]) : "v"(Bt[n]), "v"(At[m]), "v"(scw), "v"(scw));   \
        else { acc[ai][bj][m][n] = __builtin_amdgcn_mfma_f32_16x16x32_bf16(PG8_LO(Bt[n]), PG8_LO(At[m]), acc[ai][bj][m][n], 0, 0, 0); \
               acc[ai][bj][m][n] = __builtin_amdgcn_mfma_f32_16x16x32_bf16(PG8_HI(Bt[n]), PG8_HI(At[m]), acc[ai][bj][m][n], 0, 0, 0); } } \
        __builtin_amdgcn_s_setprio(0); } while (0)
#define PG8_WAIT_V(n) asm volatile("s_waitcnt vmcnt(" #n ")" ::: "memory")
#define PG8_WAIT_L(n) asm volatile("s_waitcnt lgkmcnt(" #n ")" ::: "memory")
#define PG8_BAR __builtin_amdgcn_s_barrier()
#define PG8_SCHED __builtin_amdgcn_sched_barrier(0)
#define PG8_AOFF(o, U) do { _Pragma("unroll") for (int _h = 0; _h < 2; ++_h) _Pragma("unroll") for (int _i = 0; _i < 2; ++_i) { int _R, _C; stage_rc(tid * 16 + _i * 8192, _R, _C); const int _r = _h * HALF + _R; int _row; \
        if constexpr (GATHER) { _row = J.glist[(U).lidx + (_r < (U).nvalid ? _r : (U).nvalid - 1)] >> 1; } else _row = (U).arow + _r; \
        o[_h * 2 + _i] = (unsigned)(_row * J.lda * ESZ + _C * 2); } } while (0)
    Unit cur, nxt; int ui = 0;
    if (!sched_next<MOE>(J, mm, 0, G, cu, cur)) return;
    f32x4 acc[2][2][4][2];
#pragma unroll
    for (int a = 0; a < 2; ++a)
#pragma unroll
        for (int b = 0; b < 2; ++b)
#pragma unroll
            for (int m = 0; m < 4; ++m)
#pragma unroll
                for (int n = 0; n < 2; ++n) acc[a][b][m][n] = (f32x4){0.f, 0.f, 0.f, 0.f};
    i32x8 At[4], B0[2], B1[2];
    const int scw = 0x7c7c7c7c;
    unsigned oA[4];
    PG8_AOFF(oA, cur);
    const char* cB = (const char*)J.Bt + (size_t)cur.brow * J.ldb * ESZ;
    PG8_STAGE_B(PG8_SB(0, 0), cB); PG8_STAGE_B(PG8_SB(0, 1), cB + hstepB); PG8_STAGE_A(PG8_SA(0, 0), 0, oA[0], oA[1]); PG8_STAGE_A(PG8_SA(0, 1), 0, oA[2], oA[3]);
    if (wr == 1) PG8_BAR;
    PG8_WAIT_V(2); PG8_BAR;
    PG8_STAGE_B(PG8_SB(1, 0), cB + kstep); PG8_STAGE_A(PG8_SA(1, 0), kstep, oA[0], oA[1]); PG8_STAGE_B(PG8_SB(1, 1), cB + hstepB + kstep);
    PG8_WAIT_V(6); PG8_BAR;
    for (;;) {
        bool has_next = false; const char* nB = cB; int graw[4];
        for (int t = 0; t < nt; t += 2) {
            const bool last = (t == nt - 2);
            if constexpr (GATHER) { if (t == nt - 4) {
                has_next = sched_next<MOE>(J, mm, ui + 1, G, cu, nxt);
                if (has_next) {
#pragma unroll
                    for (int h_ = 0; h_ < 2; ++h_)
#pragma unroll
                        for (int i_ = 0; i_ < 2; ++i_) { int R_, C_; stage_rc(tid * 16 + i_ * 8192, R_, C_); const int r_ = h_ * HALF + R_; const int* gp_ = J.glist + nxt.lidx + (r_ < nxt.nvalid ? r_ : nxt.nvalid - 1);
                            asm volatile("global_load_dword %0, %1, off" : "=v"(graw[h_ * 2 + i_]) : "v"(gp_) : "memory"); } } } }
            const size_t k1 = (size_t)(t + 1) * kstep;
            PG8_LDB(B0, 0, 0); PG8_LDB(B1, 0, 1); PG8_SCHED; PG8_LDA(At, 0, 0); PG8_STAGE_A(PG8_SA(1, 1), k1, oA[2], oA[3]);
            PG8_WAIT_V(8); PG8_WAIT_L(0); PG8_BAR; PG8_MMA(0, 0, At, B0); PG8_MMA(0, 1, At, B1); PG8_BAR; PG8_SCHED;
            if (last) {
                if constexpr (GATHER) { if (has_next) {
#pragma unroll
                        for (int q_ = 0; q_ < 4; ++q_) { int R_, C_; stage_rc(tid * 16 + (q_ & 1) * 8192, R_, C_); asm volatile("" : "+v"(graw[q_])); oA[q_] = (unsigned)((graw[q_] >> 1) * J.lda * ESZ + C_ * 2); }
                        nB = (const char*)J.Bt + (size_t)nxt.brow * J.ldb * ESZ; } }
                else { has_next = sched_next<MOE>(J, mm, ui + 1, G, cu, nxt); if (has_next) { PG8_AOFF(oA, nxt); nB = (const char*)J.Bt + (size_t)nxt.brow * J.ldb * ESZ; } } }
            const size_t k2 = last ? 0 : (size_t)(t + 2) * kstep, k3 = k2 + kstep;
            const char* b2 = last ? nB : cB + (size_t)(t + 2) * kstep; const char* b3 = b2 + kstep;
            PG8_LDA(At, 0, 1); PG8_STAGE_B(PG8_SB(0, 0), b2); PG8_STAGE_B(PG8_SB(0, 1), b2 + hstepB); PG8_STAGE_A(PG8_SA(0, 0), k2, oA[0], oA[1]);
            PG8_WAIT_V(8); PG8_WAIT_L(0); PG8_BAR; PG8_MMA(1, 0, At, B0); PG8_MMA(1, 1, At, B1); PG8_BAR; PG8_SCHED;
            PG8_LDB(B0, 1, 0); PG8_LDB(B1, 1, 1); PG8_SCHED; PG8_LDA(At, 1, 0); PG8_STAGE_A(PG8_SA(0, 1), k2, oA[2], oA[3]);
            PG8_WAIT_V(8); PG8_WAIT_L(0); PG8_BAR; PG8_MMA(0, 0, At, B0); PG8_MMA(0, 1, At, B1); PG8_BAR; PG8_SCHED;
            PG8_LDA(At, 1, 1); PG8_STAGE_B(PG8_SB(1, 0), b3); PG8_STAGE_B(PG8_SB(1, 1), b3 + hstepB); PG8_STAGE_A(PG8_SA(1, 0), k3, oA[0], oA[1]);
            PG8_WAIT_V(8); PG8_WAIT_L(0); PG8_BAR; PG8_MMA(1, 0, At, B0); PG8_MMA(1, 1, At, B1); PG8_BAR; PG8_SCHED;
        }
        if (wr == 0) PG8_BAR;
        if constexpr (FP8) {
            asm volatile("s_nop 15\n\ts_nop 15" : "+v"(acc[1][0][0][0]), "+v"(acc[1][0][0][1]), "+v"(acc[1][0][1][0]), "+v"(acc[1][0][1][1]), "+v"(acc[1][0][2][0]), "+v"(acc[1][0][2][1]), "+v"(acc[1][0][3][0]), "+v"(acc[1][0][3][1]),
                                              "+v"(acc[1][1][0][0]), "+v"(acc[1][1][0][1]), "+v"(acc[1][1][1][0]), "+v"(acc[1][1][1][1]), "+v"(acc[1][1][2][0]), "+v"(acc[1][1][2][1]), "+v"(acc[1][1][3][0]), "+v"(acc[1][1][3][1]) :: "memory"); }
        epilogue<EPI>(J, acc, cur, wr, wc, fr, fq);
        if (!has_next) break;
#pragma unroll
        for (int a = 0; a < 2; ++a)
#pragma unroll
            for (int b = 0; b < 2; ++b)
#pragma unroll
                for (int m = 0; m < 4; ++m)
#pragma unroll
                    for (int n = 0; n < 2; ++n) { f32x2 z0, z1; asm volatile("v_pk_mov_b32 %0, 0, 0\n\tv_pk_mov_b32 %1, 0, 0" : "=v"(z0), "=v"(z1)); acc[a][b][m][n] = (f32x4){z0.x, z0.y, z1.x, z1.y}; }
        cur = nxt; cB = nB; ++ui;
        if (wr == 1) PG8_BAR;
    }
    PG8_WAIT_V(0);
    PG8_BAR;
#undef PG8_SA
#undef PG8_SB
#undef PG8_STAGE_A
#undef PG8_STAGE_B
#undef PG8_LDA
#undef PG8_LD8
#undef PG8_LO
#undef PG8_HI
#undef PG8_LDB
#undef PG8_MMA
#undef PG8_WAIT_V
#undef PG8_WAIT_L
#undef PG8_BAR
#undef PG8_SCHED
#undef PG8_AOFF
}
}

struct Args { const void* in[30]; float* out; unsigned char* ws; int ph_lo, ph_hi; };
typedef const __attribute__((address_space(4))) Args* KArgs;
#define IN(i) ((const float*)a->in[i])
struct Frame {
    LAS unsigned char* lds; volatile LAS unsigned* MISC; gu32* ctl;
    int tid, lane, wave, G, cu;
    unsigned char* ws; float* out;
};
#define RELANE(F) do { int l_; asm volatile("v_mbcnt_lo_u32_b32 %0, -1, 0\n\tv_mbcnt_hi_u32_b32 %0, -1, %0" : "=v"(l_)); F.lane = l_; F.tid = F.wave * 64 + l_; } while (0)
enum { I_X = 0, I_C, I_POS, I_WADA, I_BADA, I_GNORM, I_WIN, I_WOUT, I_LQ1, I_LK1, I_LQ2, I_LK2, I_GDIFF, I_WCONV, I_BCONV, I_BIG, I_BFG, I_GML, I_GQL, I_GKVL, I_WUQ, I_WUKV,
       I_WGD, I_WUD, I_WDD, I_WR, I_BR, I_WGE, I_WUE, I_WDE };
__constant__ float ROPE_FREQ[16] = {1.0f, 0.5623413251903491f, 0.31622776601683794f, 0.1778279410038923f, 0.1f, 0.05623413251903491f, 0.031622776601683794f, 0.01778279410038923f,
                                    0.01f, 0.005623413251903491f, 0.0031622776601683794f, 0.001778279410038923f, 0.001f, 0.0005623413251903491f, 0.00031622776601683794f, 0.0001778279410038923f};

struct TrItem { const float* W; int N, k0, n0; int kind; bf16* dst; int ldd; const float* kscale; float wmul; };
DI void tr_load(const TrItem& t, int lane, f32x4 (&v)[8]) {
    const int kr = lane >> 3, nc0 = (lane & 7) * 4, nc = (t.n0 + nc0 + 4 <= t.N) ? nc0 : 0;
#pragma unroll
    for (int i = 0; i < 8; ++i) v[i] = __builtin_nontemporal_load((const GAS f32x4*)(t.W + (size_t)(t.k0 + 8 * i + kr) * t.N + t.n0 + nc));
}
DI int rope_perm(int i) { return (i < 16) ? ((i >> 2) * 8 + (i & 3)) : (((i - 16) >> 2) * 8 + 4 + ((i - 16) & 3)); }
struct MapIdent { DI int operator()(int n) const { return n; } };
struct MapWinP { DI int operator()(int n) const {
    if (n < 512) return n;
    if (n < 768) return -1;
    if (n < 1152) return 1024 + (n - 768);
    if (n < 1536) return 1024 + 384 + (n - 1152);
    if (n < 1920) return -1;
    if (n < 2304) return 512 + (n - 1920);
    if (n < 2316) return 1024 + 768 + (n - 2304);
    if (n < 2508) return 1024 + 784 + (n - 2316);
    if (n < 2636) return 896 + (n - 2508);
    return 1024 + 976 + rope_perm(n - 2636); } };
struct MapWinV { DI int operator()(int n) const { if (n >= 512 && n < 768) return n - 512; if (n >= 1536 && n < 1920) return 256 + (n - 1536); return -1; } };
struct MapUq { DI int operator()(int n) const { const int h = n / 96, d = n % 96; return h * 96 + (d < 64 ? d : 64 + rope_perm(d - 64)); } };
struct MapUkvK { DI int operator()(int n) const { const int h = n >> 7, d = n & 127; return d < 64 ? h * 64 + d : -1; } };
struct MapUkvV { DI int operator()(int n) const { const int h = n >> 7, d = n & 127; return d >= 64 ? h * 64 + d - 64 : -1; } };
struct MapGate { DI int operator()(int n) const { return (n >> 7) * 256 + (n & 127); } };
struct MapUp { DI int operator()(int n) const { return (n >> 7) * 256 + 128 + (n & 127); } };

enum { TK_WINP = 0, TK_WINV, TK_IDENT, TK_UQ, TK_UKVK, TK_UKVV, TK_GATE, TK_UP, TK_GATE8, TK_UP8, TK_IDENT8 };
DI int tr_map(int kind, int n) {
    switch (kind) { case TK_WINP: return MapWinP()(n); case TK_WINV: return MapWinV()(n); case TK_UQ: return MapUq()(n); case TK_UKVK: return MapUkvK()(n); case TK_UKVV: return MapUkvV()(n);
        case TK_GATE: case TK_GATE8: return MapGate()(n); case TK_UP: case TK_UP8: return MapUp()(n); default: return n; }
}
DI void tr_store(const TrItem& t, int lane, const f32x4 (&v)[8], LAS float* scr) {
    const int kr = lane >> 3, nc = (lane & 7) * 4;
#pragma unroll
    for (int i = 0; i < 8; ++i) { const int kk = 8 * i + kr;
#pragma unroll
        for (int q = 0; q < 4; ++q) scr[kk * 33 + nc + q] = v[i][q] * t.wmul; }
    LDS_WAIT(); asm volatile("" ::: "memory");
    const int c = lane & 7; const bool f8 = t.kind >= TK_GATE8;
#pragma unroll
    for (int j = 0; j < 4; ++j) { const int nl = (lane >> 3) + 8 * j, n = t.n0 + nl; const LAS float* s = scr + (8 * c) * 33 + nl;
        if (n < t.N) { const int drow = tr_map(t.kind, n);
            if (drow >= 0) {
                if (f8) { u32x2 o; o.x = pk4_fp8(s[0 * 33] * 64.f, s[1 * 33] * 64.f, s[2 * 33] * 64.f, s[3 * 33] * 64.f); o.y = pk4_fp8(s[4 * 33] * 64.f, s[5 * 33] * 64.f, s[6 * 33] * 64.f, s[7 * 33] * 64.f);
                    *(GAS u32x2*)((unsigned char*)t.dst + (size_t)drow * t.ldd + t.k0 + 8 * c) = o; }
                else { u32x4 o; o.x = cvtpk(s[0 * 33], s[1 * 33]); o.y = cvtpk(s[2 * 33], s[3 * 33]); o.z = cvtpk(s[4 * 33], s[5 * 33]); o.w = cvtpk(s[6 * 33], s[7 * 33]);
                    *(GAS u32x4*)(t.dst + (size_t)drow * t.ldd + t.k0 + 8 * c) = o; } } } }
    LDS_WAIT(); asm volatile("" ::: "memory");
}
DI void tr_decode(Frame& F, KArgs a, int it, TrItem& t) {
    unsigned char* ws = F.ws;
    constexpr int IT_WIN = 16 * 84, IT_WOUT = 16 * 32, IT_UQ = 3 * 18, IT_UKV = 2 * 24, IT_GU = 16 * 112, IT_DN = 56 * 32;
    constexpr int PER_LAYER = 2 * IT_WIN + IT_WOUT + IT_UQ + 2 * IT_UKV;
    constexpr int N_SMALL = DEPTH * PER_LAYER, N_DENSE = 2 * IT_GU + IT_DN;
    int r = it; t.kscale = nullptr; t.wmul = 1.f;
    auto set = [&](const float* W, int N, int nbn, int kind, bf16* dst, int ldd) { t.W = W; t.N = N; t.k0 = 64 * (r / nbn); t.n0 = 32 * (r % nbn); t.kind = kind; t.dst = dst; t.ldd = ldd; };
    if (r < N_SMALL) { const int l = r / PER_LAYER; r -= l * PER_LAYER;
        const float* win = IN(I_WIN) + (size_t)l * D * INW;
        if (r < IT_WIN) { set(win, INW, 84, TK_WINP, (bf16*)(ws + WS_WIN) + (size_t)l * 2048 * 1024, 1024); return; } r -= IT_WIN;
        if (r < IT_WIN) { set(win, INW, 84, TK_WINV, (bf16*)(ws + WS_WV) + (size_t)l * 768 * 1024, 1024); return; } r -= IT_WIN;
        if (r < IT_WOUT) { set(IN(I_WOUT) + (size_t)l * D * D, D, 32, TK_IDENT, (bf16*)(ws + WS_WOUT) + (size_t)l * D * D, D); return; } r -= IT_WOUT;
        if (r < IT_UQ) { set(IN(I_WUQ) + (size_t)l * 192 * 576, 576, 18, TK_UQ, (bf16*)(ws + WS_WUQ) + (size_t)l * 768 * 256, 256); return; } r -= IT_UQ;
        if (r < IT_UKV) { set(IN(I_WUKV) + (size_t)l * 128 * 768, 768, 24, TK_UKVK, (bf16*)(ws + WS_WUKK) + (size_t)l * 512 * 128, 128); return; } r -= IT_UKV;
        set(IN(I_WUKV) + (size_t)l * 128 * 768, 768, 24, TK_UKVV, (bf16*)(ws + WS_WUKV) + (size_t)l * 512 * 128, 128); return; }
    r -= N_SMALL;
    const float *wg, *wu, *wd; bf16 *gu, *dn; bool f8 = DENSE_FP8 != 0, f8d = DENSE_FP8 == 1;
    if (r < N_DENSE) { wg = IN(I_WGD); wu = IN(I_WUD); wd = IN(I_WDD); gu = (bf16*)(ws + WS_WGUD); dn = (bf16*)(ws + WS_WDD); }
    else { r -= N_DENSE; const int e = r / (2 * IT_GU + IT_DN); r -= e * (2 * IT_GU + IT_DN); f8 = true;
        wg = IN(I_WGE) + (size_t)e * D * DFF; wu = IN(I_WUE) + (size_t)e * D * DFF; wd = IN(I_WDE) + (size_t)e * DFF * D; f8d = true;
        gu = (bf16*)(ws + WS_WGUE + (size_t)e * 7168 * 1024); dn = (bf16*)(ws + WS_WDE + (size_t)e * 1024 * 3584); }
    if (r < IT_GU) { set(wg, DFF, 112, f8 ? TK_GATE8 : TK_GATE, gu, 1024); t.wmul = -1.4426950408889634f; return; } r -= IT_GU;
    if (r < IT_GU) { set(wu, DFF, 112, f8 ? TK_UP8 : TK_UP, gu, 1024); t.wmul = -0.6931471805599453f; return; } r -= IT_GU;
    set(wd, D, 32, f8d ? TK_IDENT8 : TK_IDENT, dn, 3584);
}
constexpr int TR_N_SMALL = DEPTH * (2 * 16 * 84 + 16 * 32 + 3 * 18 + 2 * 2 * 24);
constexpr int TR_N_EARLY = TR_N_SMALL + (2 * 16 * 112 + 56 * 32);
constexpr int TR_N_MOE = NEXP * (2 * 16 * 112 + 56 * 32), TR_MOE_CHUNK = 84, TR_MOE_CHUNKS = TR_N_MOE / TR_MOE_CHUNK;
static_assert(TR_MOE_CHUNKS * TR_MOE_CHUNK == TR_N_MOE && TR_MOE_CHUNKS * 4 == 2048, "expert weight items split evenly; one chunk per four mixer units");
DI void tr_run(Frame& F, KArgs a, int first, int end, int stride, LAS float* scr) {
    TrItem tA, tB, tC; f32x4 vA[8], vB[8], vC[8];
    int lane = F.lane; asm volatile("" : "+v"(lane));
    if (first >= end) return;
    const int lastit = first + ((end - 1 - first) / stride) * stride;
    int it = first;
#define TR_CL(x) ((x) <= lastit ? (x) : lastit)
    tr_decode(F, a, it, tA); tr_load(tA, lane, vA);
    tr_decode(F, a, TR_CL(it + stride), tB); tr_load(tB, lane, vB);
    for (;;) {
        tr_decode(F, a, TR_CL(it + 2 * stride), tC); tr_load(tC, lane, vC);
        tr_store(tA, lane, vA, scr); it += stride; if (it > lastit) break;
        tr_decode(F, a, TR_CL(it + 2 * stride), tA); tr_load(tA, lane, vA);
        tr_store(tB, lane, vB, scr); it += stride; if (it > lastit) break;
        tr_decode(F, a, TR_CL(it + 2 * stride), tB); tr_load(tB, lane, vB);
        tr_store(tC, lane, vC, scr); it += stride; if (it > lastit) break;
    }
#undef TR_CL
}
DI void p0_prologue(Frame& F, KArgs a) {
    LAS float* scr = (LAS float*)(F.lds + F.wave * 16384);
    const int gw = F.cu * NWAVES + F.wave, NGW = F.G * NWAVES;
    unsigned char* ws = F.ws;
    tr_run(F, a, gw, (F.G == 256) ? TR_N_SMALL : TR_N_EARLY, NGW, scr);
    { unsigned z = 0u; asm volatile("" : "+v"(z));
      for (int i = gw * 64 + F.lane; i < DEPTH * 768 * 8; i += NGW * 64) { const int row = i >> 3, c = i & 7; *(GAS u32x4*)((bf16*)(ws + WS_WUQ) + (size_t)row * 256 + 192 + c * 8) = (u32x4){z, z, z, z}; } }
    { const int* pos = (const int*)IN(I_POS); float* cs = (float*)(ws + WS_CS);
      for (int i = gw * 64 + F.lane; i < NTOK * 16; i += NGW * 64) { const int row = i >> 4, k = i & 15; const float ang = (float)pos[row] * ROPE_FREQ[k];
          double t = (double)ang * 0.15915494309189535; t -= __builtin_floor(t); const float tf = (float)t;
          cs[(size_t)row * 32 + k] = __builtin_amdgcn_cosf(tf); cs[(size_t)row * 32 + 16 + k] = __builtin_amdgcn_sinf(tf); } }
    __syncthreads();
    { LAS float* sc = (LAS float*)F.lds;
      LAS float* red = (LAS float*)(F.lds + 65536);
      const float* c = IN(I_C);
      for (int i = F.tid; i < 16 * 1024; i += NTHR) sc[(i & 1023) * 16 + (i >> 10)] = siluf(c[i]);
      __syncthreads();
      float* mod = (float*)(ws + WS_MOD);
      for (int item = F.cu; item < 4 * 48; item += F.G) { const int lj = item / 48, n0 = (item % 48) * 64;
          const float* w = IN(I_WADA) + (size_t)lj * D * 3072 + n0 + F.lane; float accv[16];
#pragma unroll
          for (int b = 0; b < 16; ++b) accv[b] = 0.f;
          const int kbeg = F.wave * 128;
          for (int k0 = kbeg; k0 < kbeg + 128; k0 += 32) { float wv[32];
#pragma unroll
              for (int i = 0; i < 32; ++i) wv[i] = w[(size_t)(k0 + i) * 3072];
#pragma unroll
              for (int i = 0; i < 32; ++i) { const LAS f32x4* sp = (const LAS f32x4*)(sc + (k0 + i) * 16); const f32x4 s0 = sp[0], s1 = sp[1], s2 = sp[2], s3 = sp[3]; const float x = wv[i];
                  accv[0] += s0.x * x; accv[1] += s0.y * x; accv[2] += s0.z * x; accv[3] += s0.w * x; accv[4] += s1.x * x; accv[5] += s1.y * x; accv[6] += s1.z * x; accv[7] += s1.w * x;
                  accv[8] += s2.x * x; accv[9] += s2.y * x; accv[10] += s2.z * x; accv[11] += s2.w * x; accv[12] += s3.x * x; accv[13] += s3.y * x; accv[14] += s3.z * x; accv[15] += s3.w * x;
                  if ((i & 3) == 3) __builtin_amdgcn_sched_barrier(0); } }
#pragma unroll
          for (int b = 0; b < 16; ++b) red[(F.wave * 16 + b) * 64 + F.lane] = accv[b];
          __syncthreads();
          for (int o = F.tid; o < 16 * 64; o += NTHR) { const int b = o >> 6, n = o & 63; float s = 0.f;
#pragma unroll
              for (int wv = 0; wv < 8; ++wv) s += red[(wv * 16 + b) * 64 + n];
              mod[((size_t)lj * 16 + b) * 3072 + n0 + n] = s + IN(I_BADA)[(size_t)lj * 3072 + n0 + n]; }
          __syncthreads(); } }
}

DI void row_load_f32(const float* p, int lane, f32x4 (&v)[4]) { const GAS f32x4* q = (const GAS f32x4*)p + lane;
#pragma unroll
    for (int j = 0; j < 4; ++j) v[j] = q[64 * j]; }
DI void row_load_bf16(const bf16* p, int lane, f32x4 (&v)[4]) { const GAS u32x2* q = (const GAS u32x2*)p + lane;
#pragma unroll
    for (int j = 0; j < 4; ++j) { const u32x2 w = q[64 * j]; v[j] = (f32x4){bflo(w.x), bfhi(w.x), bflo(w.y), bfhi(w.y)}; } }
DI void raw_load_bf16(const bf16* p, int lane, u32x2 (&w)[4]) { const GAS u32x2* q = (const GAS u32x2*)p + lane;
#pragma unroll
    for (int j = 0; j < 4; ++j) w[j] = q[64 * j]; }
DI void raw_cvt_bf16(const u32x2 (&w)[4], f32x4 (&v)[4]) {
#pragma unroll
    for (int j = 0; j < 4; ++j) v[j] = (f32x4){bflo(w[j].x), bfhi(w[j].x), bflo(w[j].y), bfhi(w[j].y)}; }
DI float row_rstd(const f32x4 (&v)[4], int lane) { float s = 0.f;
#pragma unroll
    for (int j = 0; j < 4; ++j) s += (v[j].x * v[j].x + v[j].y * v[j].y) + (v[j].z * v[j].z + v[j].w * v[j].w);
    return rsqrtf(wave_sum(s, lane) * (1.f / D) + EPS); }
DI void vec_load(const float* p, int lane, f32x4 (&v)[4]) {
#pragma unroll
    for (int j = 0; j < 4; ++j) v[j] = ((const GAS f32x4*)p)[lane + 64 * j]; }
DI void mod_norm_store(const f32x4 (&x)[4], const f32x4 (&gg)[4], const f32x4 (&sh)[4], const f32x4 (&scv)[4], bf16* orow, int lane, f32x4 (&h)[4], unsigned char* o8row = nullptr) {
    const float rstd = row_rstd(x, lane);
    GAS u32x2* o8 = (GAS u32x2*)orow + lane;
#pragma unroll
    for (int j = 0; j < 4; ++j) {
        h[j] = (x[j] * rstd * gg[j]) * (scv[j] + 1.0f) + sh[j];
        if (orow) { u32x2 w; w.x = cvtpk(h[j].x, h[j].y); w.y = cvtpk(h[j].z, h[j].w); o8[64 * j] = w; }
        if (o8row) ((GAS unsigned*)o8row)[lane + 64 * j] = pk4_fp8(h[j].x, h[j].y, h[j].z, h[j].w); }
}
DI void resid_update(f32x4 (&x)[4], const f32x4 (&y)[4], const f32x4 (&gg)[4], const f32x4 (&gt)[4], int lane) {
    const float rstd = row_rstd(y, lane);
#pragma unroll
    for (int j = 0; j < 4; ++j) x[j] = x[j] + gt[j] * (y[j] * rstd * gg[j]);
}
DI void row_store_bf16(bf16* p, int lane, const f32x4 (&v)[4]) { GAS u32x2* q = (GAS u32x2*)p + lane;
#pragma unroll
    for (int j = 0; j < 4; ++j) { u32x2 w; w.x = cvtpk(v[j].x, v[j].y); w.y = cvtpk(v[j].z, v[j].w); q[64 * j] = w; } }
DI void row_store_f32(float* p, int lane, const f32x4 (&v)[4]) { GAS f32x4* q = (GAS f32x4*)p + lane;
#pragma unroll
    for (int j = 0; j < 4; ++j) q[64 * j] = v[j]; }

DI void phase_row0(Frame& F, KArgs a) {
    const float* mod = (const float*)(F.ws + WS_MOD);
    bf16* hb = (bf16*)(F.ws + WS_HB);
    const int gw = F.cu * NWAVES + F.wave, NGW = F.G * NWAVES;
    (void)gw; (void)NGW;
    for (int blk = F.cu; blk < NTOK / 128; blk += F.G) {
        const int row0 = blk * 128 + F.wave * 16; f32x4 nx[4]; row_load_f32(IN(I_X) + (size_t)row0 * D, F.lane, nx);
        f32x4 vg[4], vsh[4], vsc[4]; { const float* m_ = mod + ((size_t)0 * 16 + (row0 >> 11)) * 3072; vec_load(IN(I_GNORM), F.lane, vg); vec_load(m_, F.lane, vsh); vec_load(m_ + 1024, F.lane, vsc); }
        for (int i = 0; i < 16; ++i) { const int row = row0 + i; f32x4 x[4], h[4];
#pragma unroll
            for (int j = 0; j < 4; ++j) x[j] = nx[j];
            if (i < 15) row_load_f32(IN(I_X) + (size_t)(row + 1) * D, F.lane, nx);
            mod_norm_store(x, vg, vsh, vsc, hb + (size_t)row * D, F.lane, h); } }
}
DI void phase_row1(Frame& F, KArgs a, int l) {
    const float* modA = (const float*)(F.ws + WS_MOD) + (size_t)(l * 2 + 0) * 16 * 3072;
    const float* modB = (const float*)(F.ws + WS_MOD) + (size_t)(l * 2 + 1) * 16 * 3072;
    const float* gn = IN(I_GNORM) + (size_t)l * 4 * D;
    const bf16* y = (const bf16*)(F.ws + WS_Y); bf16* hb = (bf16*)(F.ws + WS_HB);
    bf16* xb = (bf16*)(F.ws + WS_XB);
    const bool moe = (l & 1);
    LAS float* wr_s = (LAS float*)F.lds;
    LAS int* sel = (LAS int*)(F.lds + 32768);
    LAS int* rank = (LAS int*)(F.lds + 32768 + 512);
    LAS int* base = (LAS int*)(F.lds + 32768 + 512 + 1024);
    if (moe) { for (int i = F.tid; i < 8192; i += NTHR) wr_s[i] = IN(I_WR)[i]; __syncthreads(); }
    for (int blk = F.cu; blk < NTOK / 128; blk += F.G) {
        f32x4 vg1[4], vgt[4], vg2[4], vsh[4], vsc[4]; { const int b_ = (blk * 128) >> 11; vec_load(gn + 1 * D, F.lane, vg1); vec_load(modA + (size_t)b_ * 3072 + 2048, F.lane, vgt); vec_load(gn + 2 * D, F.lane, vg2);
            vec_load(modB + (size_t)b_ * 3072, F.lane, vsh); vec_load(modB + (size_t)b_ * 3072 + 1024, F.lane, vsc); }
        f32x4 nx[4]; u32x2 nxb[4], nyb[4];
#define R1_LOAD(row_) do { if (l == 0) row_load_f32(IN(I_X) + (size_t)(row_) * D, F.lane, nx); else raw_load_bf16(xb + (size_t)(row_) * D, F.lane, nxb); raw_load_bf16(y + (size_t)(row_) * D, F.lane, nyb); } while (0)
        R1_LOAD(blk * 128 + F.wave * 16);
        for (int i = 0; i < 16; ++i) { const int rl = F.wave * 16 + i, row = blk * 128 + rl, b = row >> 11;
            f32x4 x[4], yy[4], h[4];
            if (l == 0) {
#pragma unroll
                for (int j = 0; j < 4; ++j) x[j] = nx[j]; } else raw_cvt_bf16(nxb, x);
            raw_cvt_bf16(nyb, yy);
            if (i < 15) R1_LOAD(row + 1);
            resid_update(x, yy, vg1, vgt, F.lane); (void)b;
            row_store_bf16(xb + (size_t)row * D, F.lane, x);
            const bool f8a = moe || DENSE_FP8;
            mod_norm_store(x, vg2, vsh, vsc, f8a ? nullptr : hb + (size_t)row * D, F.lane, h, f8a ? F.ws + WS_H8 + (size_t)row * D : nullptr);
            if (moe) { float lg[8];
#pragma unroll
                for (int e = 0; e < 8; ++e) lg[e] = 0.f;
#pragma unroll
                for (int j = 0; j < 4; ++j)
#pragma unroll
                    for (int q = 0; q < 4; ++q) { const int k = 4 * F.lane + 256 * j + q; const f32x4 w0 = *(const LAS f32x4*)(wr_s + k * 8), w1 = *(const LAS f32x4*)(wr_s + k * 8 + 4); const float hv = h[j][q];
                        lg[0] += hv * w0.x; lg[1] += hv * w0.y; lg[2] += hv * w0.z; lg[3] += hv * w0.w; lg[4] += hv * w1.x; lg[5] += hv * w1.y; lg[6] += hv * w1.z; lg[7] += hv * w1.w; }
#pragma unroll
                for (int e = 0; e < 8; ++e) lg[e] = wave_sum(lg[e], F.lane) + IN(I_BR)[e];
                int e0 = 0; float v0 = lg[0];
#pragma unroll
                for (int e = 1; e < 8; ++e) if (lg[e] > v0) { v0 = lg[e]; e0 = e; }
                int e1 = -1; float v1 = -INFINITY;
#pragma unroll
                for (int e = 0; e < 8; ++e) if (e != e0 && lg[e] > v1) { v1 = lg[e]; e1 = e; }
                const float p1 = __expf(v1 - v0), g0 = 1.f / (1.f + p1), g1 = p1 / (1.f + p1);
                if (F.lane == 0) { sel[rl] = e0 | (e1 << 8); float* gt = (float*)(F.ws + WS_GATE); gt[(size_t)row * 2] = g0; gt[(size_t)row * 2 + 1] = g1; } }
        }
        if (moe) { __syncthreads();
            LAS int* wcnt = rank;
            int my_e = -1, my_r = 0;
            if (F.tid < 256) { const int rl = F.tid >> 1, k = F.tid & 1; const int s = sel[rl]; my_e = k ? (s >> 8) : (s & 255);
                const unsigned long long below = (1ull << F.lane) - 1ull;
#pragma unroll
                for (int e = 0; e < 8; ++e) { const unsigned long long m = __builtin_amdgcn_ballot_w64(my_e == e); if (my_e == e) my_r = __builtin_popcountll(m & below);
                    if (F.lane == 0) wcnt[F.wave * 8 + e] = __builtin_popcountll(m); } }
            __syncthreads();
            if (F.tid < 8) { const int e = F.tid; const int n = wcnt[e] + wcnt[8 + e] + wcnt[16 + e] + wcnt[24 + e];
                base[e] = (int)__hip_atomic_fetch_add((unsigned*)(F.ctl + CW_MOECNT + e), (unsigned)n, __ATOMIC_RELAXED, __HIP_MEMORY_SCOPE_AGENT); }
            __syncthreads();
            if (F.tid < 256) { int off = base[my_e] + my_r;
                for (int w2 = 0; w2 < F.wave; ++w2) off += wcnt[w2 * 8 + my_e];
                int* list = (int*)(F.ws + WS_LIST); list[my_e * 32768 + off] = (blk * 128 + (F.tid >> 1)) * 2 + (F.tid & 1); }
            __syncthreads(); }
    }
#undef R1_LOAD
}
DI void phase_row2(Frame& F, KArgs a, int l) {
    const float* modB = (const float*)(F.ws + WS_MOD) + (size_t)(l * 2 + 1) * 16 * 3072;
    const float* gn = IN(I_GNORM) + (size_t)l * 4 * D;
    bf16* hb = (bf16*)(F.ws + WS_HB);
    const bool moe = (l & 1);
    const int gw = F.cu * NWAVES + F.wave, NGW = F.G * NWAVES;
    (void)gw; (void)NGW;
    for (int blk = F.cu; blk < NTOK / 128; blk += F.G) {
      f32x4 vg3[4], vgt[4], vgn[4], vsh[4], vsc[4]; { const int b_ = (blk * 128) >> 11; vec_load(gn + 3 * D, F.lane, vg3); vec_load(modB + (size_t)b_ * 3072 + 2048, F.lane, vgt);
          if (l + 1 < DEPTH) { const float* modN_ = (const float*)(F.ws + WS_MOD) + (size_t)((l + 1) * 2) * 16 * 3072 + (size_t)b_ * 3072; vec_load(IN(I_GNORM) + (size_t)(l + 1) * 4 * D, F.lane, vgn); vec_load(modN_, F.lane, vsh); vec_load(modN_ + 1024, F.lane, vsc); } }
      u32x2 nxb[4], nya[4], nyb[4]; float ng0 = 0.f, ng1 = 0.f;
#define R2_LOAD(row_) do { raw_load_bf16((const bf16*)(F.ws + WS_XB) + (size_t)(row_) * D, F.lane, nxb); \
        if (!moe) raw_load_bf16((const bf16*)(F.ws + WS_Y2) + (size_t)(row_) * D, F.lane, nya); \
        else { const bf16* ym_ = (const bf16*)(F.ws + WS_YM); const float* gt_ = (const float*)(F.ws + WS_GATE); raw_load_bf16(ym_ + (size_t)((row_) * 2) * D, F.lane, nya); raw_load_bf16(ym_ + (size_t)((row_) * 2 + 1) * D, F.lane, nyb); \
               ng0 = gt_[(size_t)(row_) * 2]; ng1 = gt_[(size_t)(row_) * 2 + 1]; } } while (0)
      R2_LOAD(blk * 128 + F.wave * 16);
      for (int i = 0; i < 16; ++i) { const int row = blk * 128 + F.wave * 16 + i, b = row >> 11; f32x4 x[4], yy[4];
        raw_cvt_bf16(nxb, x);
        if (!moe) raw_cvt_bf16(nya, yy);
        else { f32x4 ya[4], yb[4]; raw_cvt_bf16(nya, ya); raw_cvt_bf16(nyb, yb); const float g0 = ng0, g1 = ng1;
#pragma unroll
            for (int j = 0; j < 4; ++j) yy[j] = ya[j] * g0 + yb[j] * g1; }
        if (i < 15) R2_LOAD(row + 1);
        resid_update(x, yy, vg3, vgt, F.lane); (void)b;
        if (l + 1 < DEPTH) row_store_bf16((bf16*)(F.ws + WS_XB) + (size_t)row * D, F.lane, x); else row_store_f32(F.out + (size_t)row * D, F.lane, x);
        if (l + 1 < DEPTH) { f32x4 h[4]; mod_norm_store(x, vgn, vsh, vsc, hb + (size_t)row * D, F.lane, h); }
      } }
#undef R2_LOAD
}

DI void phase_fix(Frame& F, KArgs a, int l) {
    const bf16* P1 = (const bf16*)(F.ws + WS_P1); const bf16* P2 = (const bf16*)(F.ws + WS_P2);
    const int gw = F.cu * NWAVES + F.wave, NGW = F.G * NWAVES;
    float* bt2 = (float*)(F.ws + WS_BT2); float* a2 = (float*)(F.ws + WS_A2);
    for (int it = F.cu; it < 96; it += F.G) { const int b = it / 6, h = it % 6; const float bi = IN(I_BIG)[l * 6 + h], bfg = IN(I_BFG)[l * 6 + h];
        LAS float* wt = (LAS float*)F.lds;
        const int t0 = F.wave * 256 + F.lane * 4; float lf[4], ig[4]; float tot = 0.f;
#pragma unroll
        for (int i = 0; i < 4; ++i) { const size_t row = (size_t)b * SEQ + t0 + i; const float fg = bf2f(P2[row * 1024 + 774 + h]) + bfg; ig[i] = bf2f(P2[row * 1024 + 768 + h]) + bi;
            const float ls = (fg >= 0.f) ? -__logf(1.f + __expf(-fg)) : fg - __logf(1.f + __expf(fg)); tot += ls; lf[i] = tot; }
        float incl = tot;
#pragma unroll
        for (int o = 1; o < 64; o <<= 1) { const float t = lane_read(incl, F.lane - o); if (F.lane >= o) incl += t; }
        const float excl = incl - tot;
        if (F.lane == 63) wt[F.wave] = incl;
        __syncthreads();
        float base = 0.f;
        for (int w2 = 0; w2 < F.wave; ++w2) base += wt[w2];
        f32x4 Bv, Av;
#pragma unroll
        for (int i = 0; i < 4; ++i) { const float B = (base + excl + lf[i]) * LOG2E; Bv[i] = B; Av[i] = ig[i] * LOG2E - B; }
        const size_t o = (size_t)it * SEQ + t0; *(GAS f32x4*)(bt2 + o) = Bv; *(GAS f32x4*)(a2 + o) = Av;
        __syncthreads();
    }
    bf16* cqn = (bf16*)(F.ws + WS_CQN); bf16* ckvn = (bf16*)(F.ws + WS_CKVN); bf16* kc = (bf16*)(F.ws + WS_KC); bf16* qbc = (bf16*)(F.ws + WS_QBC); bf16* kbc = (bf16*)(F.ws + WS_KBC);
    const float* cs = (const float*)(F.ws + WS_CS);
    const float* wconv = IN(I_WCONV) + (size_t)l * 4 * 768; const float* bconv = IN(I_BCONV) + (size_t)l * 768;
    for (int run = gw; run < NTOK / 16; run += NGW) {
    const int row0 = run * 16; u32x2 pv[3][3]; f32x4 wcv[4][3], bcv[3];
#pragma unroll
    for (int g = 0; g < 3; ++g) { const int ch = (g * 64 + F.lane) * 4; bcv[g] = *(const GAS f32x4*)(bconv + ch);
#pragma unroll
        for (int j = 0; j < 4; ++j) wcv[j][g] = *(const GAS f32x4*)(wconv + j * 768 + ch);
#pragma unroll
        for (int j = 0; j < 3; ++j) { pv[j][g] = (u32x2){0u, 0u}; if ((row0 & (SEQ - 1)) - 3 + j >= 0) pv[j][g] = *(const GAS u32x2*)(P2 + (size_t)(row0 - 3 + j) * 1024 + ch); } }
    f32x4 gq4 = {0.f, 0.f, 0.f, 0.f}; if (F.lane < 48) gq4 = *(const GAS f32x4*)(IN(I_GQL) + l * 192 + 4 * F.lane);
    const f32x2 gk2 = *(const GAS f32x2*)(IN(I_GKVL) + l * 128 + 2 * F.lane);
    const int kg = (F.lane >> 2) & 3, kj = F.lane & 3;
    u32x2 n_cq = {0u, 0u}, n_cur[3]; unsigned n_ckv; unsigned short n_u1, n_u2; float n_c, n_sn;
#define FIX_LOAD(row_) do { const size_t r_ = (size_t)(row_); n_cq = (u32x2){0u, 0u}; if (F.lane < 48) n_cq = *(const GAS u32x2*)(P2 + r_ * 1024 + 784 + 4 * F.lane); \
        n_ckv = *(const GAS unsigned*)(P1 + r_ * 1024 + 896 + 2 * F.lane); \
        n_u1 = *(const GAS unsigned short*)(P2 + r_ * 1024 + 976 + kg * 8 + kj); n_u2 = *(const GAS unsigned short*)(P2 + r_ * 1024 + 976 + kg * 8 + 4 + kj); \
        n_c = cs[r_ * 32 + kg * 4 + kj]; n_sn = cs[r_ * 32 + 16 + kg * 4 + kj]; \
        _Pragma("unroll") for (int g_ = 0; g_ < 3; ++g_) n_cur[g_] = *(const GAS u32x2*)(P2 + r_ * 1024 + (g_ * 64 + F.lane) * 4); } while (0)
    FIX_LOAD(row0);
    for (int ri = 0; ri < 16; ++ri) { const int row = row0 + ri;
        const u32x2 w_cq = n_cq; const unsigned w_ckv = n_ckv; const float u1 = bf2f(n_u1), u2 = bf2f(n_u2), c = n_c, sn = n_sn; u32x2 curv[3];
#pragma unroll
        for (int g = 0; g < 3; ++g) curv[g] = n_cur[g];
        if (ri < 15) FIX_LOAD(row + 1);
        { const float v0 = bflo(w_cq.x), v1 = bfhi(w_cq.x), v2 = bflo(w_cq.y), v3 = bfhi(w_cq.y), k0 = bflo(w_ckv), k1 = bfhi(w_ckv);
          float sq = v0 * v0 + v1 * v1 + v2 * v2 + v3 * v3, sk = k0 * k0 + k1 * k1; wave_sum2(sq, sk, F.lane);
          const float rq = rsqrtf(sq * (1.f / 192.f) + EPS), rk = rsqrtf(sk * (1.f / 128.f) + EPS);
          u32x2 o; o.x = cvtpk(v0 * rq * gq4.x, v1 * rq * gq4.y); o.y = cvtpk(v2 * rq * gq4.z, v3 * rq * gq4.w); *(GAS u32x2*)(cqn + (size_t)row * 256 + 4 * F.lane) = o;
          *(GAS unsigned*)(ckvn + (size_t)row * 128 + 2 * F.lane) = cvtpk(k0 * rk * gk2.x, k1 * rk * gk2.y); }
        { const int g = kg, j = kj; const float o1 = u1 * c - u2 * sn, o2 = u1 * sn + u2 * c;
          if (F.lane < 16) {
#pragma unroll
              for (int h = 0; h < 6; ++h) { kc[(size_t)row * 576 + h * 96 + 64 + g * 8 + j] = (bf16)(cvtpk(o1, 0.f) & 0xffffu); kc[(size_t)row * 576 + h * 96 + 64 + g * 8 + 4 + j] = (bf16)(cvtpk(o2, 0.f) & 0xffffu); } } }
#pragma unroll
        for (int g = 0; g < 3; ++g) { const int ch = (g * 64 + F.lane) * 4; float accv[4];
            const u32x2 cur = curv[g];
#pragma unroll
            for (int q = 0; q < 4; ++q) accv[q] = bcv[g][q];
#pragma unroll
            for (int j = 0; j < 4; ++j) { const u32x2 w = (j < 3) ? pv[j][g] : cur; const f32x4 wc = wcv[j][g];
                accv[0] += bflo(w.x) * wc.x; accv[1] += bfhi(w.x) * wc.y; accv[2] += bflo(w.y) * wc.z; accv[3] += bfhi(w.y) * wc.w; }
            pv[0][g] = pv[1][g]; pv[1][g] = pv[2][g]; pv[2][g] = cur;
            const float sc = (ch >= 384) ? 0.125f : 1.0f;
            u32x2 o; o.x = cvtpk(siluf(accv[0]) * sc, siluf(accv[1]) * sc); o.y = cvtpk(siluf(accv[2]) * sc, siluf(accv[3]) * sc);
            if (ch < 384) *(GAS u32x2*)(qbc + (size_t)row * 384 + ch) = o; else *(GAS u32x2*)(kbc + (size_t)row * 384 + ch - 384) = o; }
#undef FIX_LOAD
    } }
}

#define MFMA32(a, b, c) __builtin_amdgcn_mfma_f32_32x32x16_bf16((a), (b), (c), 0, 0, 0)
template <int DQK> struct AttnLds { static constexpr int KP = DQK + 8; static constexpr int KBYTES = 64 * KP * 2; static constexpr int VP = 68, VBYTES = 64 * VP * 2; };
constexpr int ATT_K_OFF = 0, ATT_V_OFF = 40960, ATT_G_OFF = 61440;

template <int DQK> DI void attn_qk(const LAS unsigned char* Kb, const bf16x8 (&qf)[DQK / 16], f32x16& s0, f32x16& s1, int r32, int hi) {
    typedef AttnLds<DQK> L; constexpr int KS = DQK / 16;
    s0 = f32x16{}; s1 = f32x16{};
    constexpr int BS = (KS > 2) ? 2 : KS;
#pragma unroll
    for (int b0 = 0; b0 < KS; b0 += BS) { bf16x8 k0[BS], k1[BS];
#pragma unroll
        for (int i = 0; i < BS; ++i) { k0[i] = *(const LAS bf16x8*)(Kb + (r32 * L::KP + (b0 + i) * 16 + hi * 8) * 2); k1[i] = *(const LAS bf16x8*)(Kb + ((32 + r32) * L::KP + (b0 + i) * 16 + hi * 8) * 2); }
        __builtin_amdgcn_sched_barrier(0);
#pragma unroll
        for (int i = 0; i < BS; ++i) { s0 = MFMA32(k0[i], qf[b0 + i], s0); s1 = MFMA32(k1[i], qf[b0 + i], s1); }
        __builtin_amdgcn_sched_barrier(0); }
}
template <int DQK, bool MLSTM>
DI void attn_sm_pv(f32x16& s0, f32x16& s1, const LAS unsigned char* Vb, const LAS float* gs, f32x16 (&o)[2], float& lsum, float& mrun, float cscale, float bt2q, bool diag, int tq, int r32, int hi) {
    typedef AttnLds<DQK> L;
    if (!MLSTM) {
        float mx = s0[0];
#pragma unroll
        for (int r = 1; r < 16; ++r) mx = fmaxf(mx, s0[r]);
#pragma unroll
        for (int r = 0; r < 16; ++r) mx = fmaxf(mx, s1[r]);
        mx = half_swap_max(mx);
        if (__builtin_amdgcn_ballot_w64(mx > mrun) != 0ull) {
            const float mnew = fmaxf(mrun, mx), alpha = __builtin_amdgcn_exp2f((mrun - mnew) * cscale); mrun = mnew; lsum *= alpha;
#pragma unroll
            for (int r = 0; r < 16; ++r) { o[0][r] *= alpha; o[1][r] *= alpha; } }
        const float mc = mrun * cscale; float ps = 0.f;
#ifdef ATT_DBL_SM
        { f32x16 t0 = s0, t1 = s1; float mx2 = t0[0];
#pragma unroll
          for (int r = 1; r < 16; ++r) mx2 = fmaxf(mx2, t0[r] * 1.0001f);
#pragma unroll
          for (int r = 0; r < 16; ++r) mx2 = fmaxf(mx2, t1[r] * 1.0001f);
          float ps2 = mx2;
#pragma unroll
          for (int r = 0; r < 16; ++r) { t0[r] = __builtin_amdgcn_exp2f(t0[r] * cscale - mc * 1.0001f); t1[r] = __builtin_amdgcn_exp2f(t1[r] * cscale - mc * 1.0001f); ps2 += t0[r] + t1[r]; }
          unsigned acc2 = 0;
#pragma unroll
          for (int r = 0; r < 16; r += 2) { acc2 ^= cvtpk(t0[r], t0[r + 1]); acc2 ^= cvtpk(t1[r], t1[r + 1]); }
          asm volatile("" :: "v"(ps2), "v"(acc2)); }
#endif
#pragma unroll
        for (int r = 0; r < 16; ++r) { s0[r] = __builtin_amdgcn_exp2f(s0[r] * cscale - mc); s1[r] = __builtin_amdgcn_exp2f(s1[r] * cscale - mc); ps += s0[r] + s1[r]; }
        lsum += ps;
    } else {
        float ps = 0.f;
#pragma unroll
        for (int g = 0; g < 4; ++g) { const f32x4 ga = *(const LAS f32x4*)(gs + 8 * g + 4 * hi), gb = *(const LAS f32x4*)(gs + 32 + 8 * g + 4 * hi);
#pragma unroll
            for (int q = 0; q < 4; ++q) { const int r = 4 * g + q, key = 8 * g + 4 * hi + q;
                float w0 = __builtin_amdgcn_exp2f(bt2q + ga[q]), w1 = __builtin_amdgcn_exp2f(bt2q + gb[q]);
                if (diag) { if (key > tq) w0 = 0.f; if (key + 32 > tq) w1 = 0.f; }
                s0[r] *= w0; s1[r] *= w1; ps += s0[r] + s1[r]; } }
        lsum += ps;
    }
    bf16x8 pf[4];
#pragma unroll
    for (int s = 0; s < 2; ++s) { u32x4 t0, t1;
        t0.x = cvtpk(s0[8 * s + 0], s0[8 * s + 1]); t0.y = cvtpk(s0[8 * s + 2], s0[8 * s + 3]); t0.z = cvtpk(s0[8 * s + 4], s0[8 * s + 5]); t0.w = cvtpk(s0[8 * s + 6], s0[8 * s + 7]);
        t1.x = cvtpk(s1[8 * s + 0], s1[8 * s + 1]); t1.y = cvtpk(s1[8 * s + 2], s1[8 * s + 3]); t1.z = cvtpk(s1[8 * s + 4], s1[8 * s + 5]); t1.w = cvtpk(s1[8 * s + 6], s1[8 * s + 7]);
        pf[s] = __builtin_bit_cast(bf16x8, t0); pf[2 + s] = __builtin_bit_cast(bf16x8, t1); }
    { u32x4 av0[4], av1[4];
#define ATT_VRD(dst, d) do { _Pragma("unroll") for (int kk = 0; kk < 4; ++kk) { const int kbase = 32 * (kk >> 1) + 16 * (kk & 1) + 4 * hi; const LAS unsigned char* vp = Vb + ((32 * (d) + r32) * L::VP + kbase) * 2; \
          const u32x2 lo = *(const LAS u32x2*)vp, hh = *(const LAS u32x2*)(vp + 16); dst[kk] = (u32x4){lo.x, lo.y, hh.x, hh.y}; } } while (0)
      ATT_VRD(av0, 0);
      __builtin_amdgcn_sched_barrier(0);
      ATT_VRD(av1, 1);
#pragma unroll
      for (int kk = 0; kk < 4; ++kk) o[0] = MFMA32(__builtin_bit_cast(bf16x8, av0[kk]), pf[kk], o[0]);
      __builtin_amdgcn_sched_barrier(0);
#pragma unroll
      for (int kk = 0; kk < 4; ++kk) o[1] = MFMA32(__builtin_bit_cast(bf16x8, av1[kk]), pf[kk], o[1]);
      __builtin_amdgcn_sched_barrier(0);
#undef ATT_VRD
    }
}
#define SB_ __builtin_amdgcn_sched_barrier(0)
template <int DQK, bool DOQK = true, bool CI = false>
DI void attn_step_fused(const LAS unsigned char* Kb, const bf16x8 (&qf)[DQK / 16], f32x16& n0, f32x16& n1, f32x16& s0, f32x16& s1, const LAS unsigned char* Vb, f32x16 (&o)[2], float& lsum, float& mrun, float cscale, int r32, int hi, f32x16* negm = nullptr) {
    typedef AttnLds<DQK> L; constexpr int KS = DQK / 16; static_assert(KS == 6 || KS == 4 || KS == 2, "");
    constexpr int FVP = 72;
    bf16x8 ka[2], kb[2]; u32x4 va[2][2]; bf16x8 pf[4];
#define FS_LDK(b0_) do { _Pragma("unroll") for (int i = 0; i < 2; ++i) { ka[i] = *(const LAS bf16x8*)(Kb + (r32 * L::KP + ((b0_) + i) * 16 + hi * 8) * 2); kb[i] = *(const LAS bf16x8*)(Kb + ((32 + r32) * L::KP + ((b0_) + i) * 16 + hi * 8) * 2); } } while (0)
#define FS_LDV(slot, kk) do { _Pragma("unroll") for (int d = 0; d < 2; ++d) va[slot][d] = *(const LAS u32x4*)(Vb + ((32 * d + r32) * FVP + 16 * (kk) + 8 * hi) * 2); } while (0)
#define FS_EXPG(S, r) do { if constexpr (CI) { S[r] = __builtin_amdgcn_exp2f(S[r]); S[(r) + 1] = __builtin_amdgcn_exp2f(S[(r) + 1]); } \
        else { S[r] = __builtin_amdgcn_exp2f(S[r] * cscale - mc); S[(r) + 1] = __builtin_amdgcn_exp2f(S[(r) + 1] * cscale - mc); } ps += S[r] + S[(r) + 1]; } while (0)
#define FS_CVT(dst, S, r) do { u32x4 t_; t_.x = cvtpk(S[(r) + 0], S[(r) + 1]); t_.y = cvtpk(S[(r) + 2], S[(r) + 3]); t_.z = cvtpk(S[(r) + 4], S[(r) + 5]); t_.w = cvtpk(S[(r) + 6], S[(r) + 7]); dst = __builtin_bit_cast(bf16x8, t_); } while (0)
#define FS_PV(kk, d, slot) do { o[d] = MFMA32(__builtin_bit_cast(bf16x8, va[slot][d]), pf[kk], o[d]); } while (0)
    if constexpr (DOQK) { FS_LDK(0); } SB_;
    float mx = s0[0];
#pragma unroll
    for (int r = 1; r < 16; ++r) mx = fmaxf(mx, s0[r]);
#pragma unroll
    for (int r = 0; r < 16; ++r) mx = fmaxf(mx, s1[r]);
    mx = half_swap_max(mx);
    SB_;
    if constexpr (CI) {
        if (__builtin_amdgcn_ballot_w64(mx > 8.f) != 0ull) {
            const float delta = mx > 8.f ? mx : 0.f, alpha = __builtin_amdgcn_exp2f(-delta); lsum *= alpha;
#pragma unroll
            for (int r = 0; r < 16; ++r) { o[0][r] *= alpha; o[1][r] *= alpha; s0[r] -= delta; s1[r] -= delta; (*negm)[r] -= delta; } }
        SB_;
        if constexpr (DOQK) { n0 = MFMA32(ka[0], qf[0], *negm); SB_; n1 = MFMA32(kb[0], qf[0], *negm); SB_; }
    } else {
    if constexpr (DOQK) { n0 = MFMA32(ka[0], qf[0], f32x16{}); SB_;
    n1 = MFMA32(kb[0], qf[0], f32x16{}); SB_; }
    if (__builtin_amdgcn_ballot_w64((mx - mrun) * cscale > 8.f) != 0ull) {
        const float mnew = ((mx - mrun) * cscale > 8.f) ? mx : mrun, alpha = __builtin_amdgcn_exp2f((mrun - mnew) * cscale); mrun = mnew; lsum *= alpha;
#pragma unroll
        for (int r = 0; r < 16; ++r) { o[0][r] *= alpha; o[1][r] *= alpha; } }
    }
    const float mc = mrun * cscale; float ps = 0.f; (void)mc;
    SB_;
    if constexpr (DOQK) { n0 = MFMA32(ka[1], qf[1], n0); SB_; }
    FS_EXPG(s0, 0); SB_;
    if constexpr (DOQK) { n1 = MFMA32(kb[1], qf[1], n1); SB_; }
    if constexpr (DOQK && KS >= 4) { FS_LDK(2); } FS_LDV(0, 0); SB_;
    FS_EXPG(s0, 2); FS_EXPG(s0, 4); FS_EXPG(s0, 6); SB_;
    FS_CVT(pf[0], s0, 0); SB_;
    if constexpr (DOQK && KS >= 4) {
        n0 = MFMA32(ka[0], qf[2], n0); SB_; FS_EXPG(s0, 8); SB_;
        n1 = MFMA32(kb[0], qf[2], n1); SB_; FS_EXPG(s0, 10); SB_;
        n0 = MFMA32(ka[1], qf[3], n0); SB_; FS_EXPG(s0, 12); SB_;
        n1 = MFMA32(kb[1], qf[3], n1); SB_; FS_EXPG(s0, 14); SB_;
    } else { FS_EXPG(s0, 8); FS_EXPG(s0, 10); FS_EXPG(s0, 12); FS_EXPG(s0, 14); SB_; }
    if constexpr (DOQK && KS >= 6) { FS_LDK(4); } FS_LDV(1, 1); SB_;
    FS_CVT(pf[1], s0, 8); SB_;
    FS_PV(0, 0, 0); SB_; FS_EXPG(s1, 0); SB_;
    FS_PV(0, 1, 0); SB_; FS_EXPG(s1, 2); SB_;
    FS_LDV(0, 2); SB_;
    if constexpr (DOQK && KS >= 6) {
        n0 = MFMA32(ka[0], qf[4], n0); SB_; FS_EXPG(s1, 4); SB_;
        n1 = MFMA32(kb[0], qf[4], n1); SB_; FS_EXPG(s1, 6); SB_;
        n0 = MFMA32(ka[1], qf[5], n0); SB_; FS_CVT(pf[2], s1, 0); SB_;
        n1 = MFMA32(kb[1], qf[5], n1); SB_; FS_EXPG(s1, 8); SB_;
    } else { FS_EXPG(s1, 4); FS_EXPG(s1, 6); SB_; FS_CVT(pf[2], s1, 0); SB_; FS_EXPG(s1, 8); SB_; }
    FS_PV(1, 0, 1); SB_; FS_EXPG(s1, 10); SB_;
    FS_PV(1, 1, 1); SB_; FS_EXPG(s1, 12); SB_;
    FS_LDV(1, 3); SB_;
    FS_PV(2, 0, 0); SB_; FS_EXPG(s1, 14); SB_;
    FS_PV(2, 1, 0); SB_; FS_CVT(pf[3], s1, 8); lsum += ps; SB_;
    FS_PV(3, 0, 1); SB_;
    FS_PV(3, 1, 1); SB_;
#undef FS_LDK
#undef FS_LDV
#undef FS_EXPG
#undef FS_CVT
#undef FS_PV
}
template <int DQK, bool MLSTM>
DI void attn_pass(Frame& F, const bf16* Qp, int qpitch, const bf16* Kp, int kpitch, const bf16* Vt, const float* a2g  , float bt2q, int b, int qb, float cscale,
                  f32x16 (&o)[2], float& lsum, int t0 = 0  ) {
    typedef AttnLds<DQK> L;
    constexpr bool CIM = !MLSTM && ATT_FUSED && ATT_CINIT;
    constexpr bool VPM = !MLSTM && ATT_FUSED; constexpr int VPx = VPM ? 72 : L::VP, VBx = 64 * VPx * 2;
    constexpr int KS = DQK / 16, KPIECES = 64 * DQK / 8, KREG = (KPIECES + NTHR - 1) / NTHR;
    const int lane = F.lane, r32 = lane & 31, hi = lane >> 5, w = F.wave;
    const int NT = 4 * qb + 4, myc = 4 * qb + (w >> 1);
    LAS unsigned char* lds = F.lds;
    bf16x8 qf[KS];
    { const bf16* qrow = Qp + (size_t)(b * SEQ + qb * 256 + w * 32 + r32) * qpitch;
#pragma unroll
      for (int ks = 0; ks < KS; ++ks) qf[ks] = *(const GAS bf16x8*)(qrow + ks * 16 + hi * 8); }
    o[0] = f32x16{}; o[1] = f32x16{}; lsum = 0.f; float mrun = -INFINITY; f32x16 negm = f32x16{};
    u32x4 kregA[KREG], vregA, kregB[KREG], vregB; float gregA = 0.f, gregB = 0.f;
    const int vrow = F.tid >> 3, vc = F.tid & 7, tq = (w & 1) * 32 + r32;
    unsigned koff[KREG];
#pragma unroll
    for (int q_ = 0; q_ < KREG; ++q_) { const int p_ = (F.tid + q_ * NTHR < KPIECES) ? F.tid + q_ * NTHR : F.tid, row_ = p_ / (DQK / 8), c_ = p_ % (DQK / 8); koff[q_] = (unsigned)(row_ * kpitch + c_ * 8) * 2u; }
    const unsigned voff = (unsigned)(((F.tid >> 3) * NTOK + (F.tid & 7) * 8) * 2);
    const char* const wsb = (const char*)F.ws;
    const unsigned kb32 = (unsigned)((const char*)Kp - wsb) + (unsigned)b * (unsigned)(SEQ * 2) * (unsigned)kpitch, vb32 = (unsigned)((const char*)Vt - wsb) + (unsigned)b * (unsigned)(SEQ * 2);
#define ATT_LOADK(KR, kt) do { const unsigned kt_ = kb32 + (unsigned)(kt) * (unsigned)(64 * 2) * (unsigned)kpitch; \
        _Pragma("unroll") for (int q_ = 0; q_ < KREG; ++q_) KR[q_] = *(const GAS u32x4*)(wsb + (size_t)(kt_ + koff[q_])); } while (0)
#define ATT_WRITEK(KR, kbuf) do { \
        _Pragma("unroll") for (int q_ = 0; q_ < KREG; ++q_) { const int p_ = F.tid + q_ * NTHR; if (p_ < KPIECES) { const int row_ = p_ / (DQK / 8), c_ = p_ % (DQK / 8); \
            *(LAS u32x4*)(lds + ATT_K_OFF + (kbuf) * 13312 + (row_ * L::KP + c_ * 8) * 2) = KR[q_]; } } } while (0)
#define ATT_LOAD(KR, VR, GR, j) do { ATT_LOADK(KR, ((j) + 1 < NT) ? (j) + 1 : NT - 1); \
        VR = *(const GAS u32x4*)(wsb + (size_t)(vb32 + (unsigned)(j) * 128u + voff)); \
        if constexpr (MLSTM) GR = a2g[(j) * 64 + (F.tid & 63)]; } while (0)
#define ATT_WRITE(KR, VR, GR, buf) do { ATT_WRITEK(KR, buf); \
        { LAS u32x2* vp_ = (LAS u32x2*)(lds + ATT_V_OFF + (buf) * VBx + (vrow * VPx + (VPM ? (vc >> 1) * 16 + (vc & 1) * 4 : vc * 8)) * 2); vp_[0] = (u32x2){VR.x, VR.y}; vp_[VPM ? 2 : 1] = (u32x2){VR.z, VR.w}; } \
        if (MLSTM && F.tid < 64) *(LAS float*)(lds + ATT_G_OFF + (buf) * 256 + F.tid * 4) = GR; } while (0)
#define ATT_STEP(j, buf, SC0, SC1, SN0, SN1) do { \
        if constexpr (!MLSTM && ATT_FUSED) {   \
            if ((j) <= myc) attn_step_fused<DQK, true, CIM>(lds + ATT_K_OFF + (buf) * 13312, qf, SN0, SN1, SC0, SC1, lds + ATT_V_OFF + (buf) * VBx, o, lsum, mrun, cscale, r32, hi, &negm); } \
        else { \
        if ((j) + 1 <= myc) { ATT_DBLQK(buf); attn_qk<DQK>(lds + ATT_K_OFF + (buf) * 13312, qf, SN0, SN1, r32, hi); } \
        if ((j) <= myc) attn_sm_pv<DQK, MLSTM>(SC0, SC1, lds + ATT_V_OFF + (buf) * L::VBYTES, (const LAS float*)(lds + ATT_G_OFF + (buf) * 256), o, lsum, mrun, cscale, bt2q, (j) == myc, tq, r32, hi); } } while (0)
#ifdef ATT_DBL_QK
#define ATT_DBLQK(buf) do { f32x16 t0_, t1_; attn_qk<DQK>(lds + ATT_K_OFF + (buf) * 13312, qf, t0_, t1_, r32, hi); asm volatile("" :: "v"(t0_), "v"(t1_)); } while (0)
#else
#define ATT_DBLQK(buf) do {} while (0)
#endif
    f32x16 sa0, sa1, sb0, sb1;
    ATT_LOADK(kregB, t0); ATT_LOAD(kregA, vregA, gregA, t0);
    ATT_WRITEK(kregB, 2); ATT_WRITE(kregA, vregA, gregA, 0);
    ATT_LOAD(kregA, vregA, gregA, t0 + 1);
    __syncthreads();
    attn_qk<DQK>(lds + ATT_K_OFF + 2 * 13312, qf, sa0, sa1, r32, hi);
    if constexpr (CIM) { float mx = sa0[0];
#pragma unroll
        for (int r = 1; r < 16; ++r) mx = fmaxf(mx, sa0[r]);
#pragma unroll
        for (int r = 0; r < 16; ++r) mx = fmaxf(mx, sa1[r]);
        mx = half_swap_max(mx);
#pragma unroll
        for (int r = 0; r < 16; ++r) { sa0[r] -= mx; sa1[r] -= mx; negm[r] = -mx; } }
    if (w >= 4) __builtin_amdgcn_s_setprio(1);
    for (int j = t0; j < NT; j += 2) {
        ATT_LOAD(kregB, vregB, gregB, (j + 2 < NT) ? j + 2 : NT - 1);
        ATT_STEP(j, 0, sa0, sa1, sb0, sb1);
        ATT_WRITE(kregA, vregA, gregA, 1);
        __syncthreads();
        ATT_LOAD(kregA, vregA, gregA, (j + 3 < NT) ? j + 3 : NT - 1);
        ATT_STEP(j + 1, 1, sb0, sb1, sa0, sa1);
        if (j + 2 < NT) ATT_WRITE(kregB, vregB, gregB, 0);
        __syncthreads();
    }
    __builtin_amdgcn_s_setprio(0);
#undef ATT_LOADK
#undef ATT_WRITEK
#undef ATT_LOAD
#undef ATT_WRITE
#undef ATT_STEP
}
DI void attn_pass_diff(Frame& F, const bf16* P1h  , const bf16* Vt, int b, int qb, float cscale,
                       f32x16 (&o1)[2], float& l1, f32x16 (&o2)[2], float& l2) {
    typedef AttnLds<32> L;
    int lane = F.lane; asm volatile("" : "+v"(lane));
    const int r32 = lane & 31, hi = lane >> 5, w = F.wave, tid = w * 64 + lane;
    const int NT = 4 * qb + 4, myc = 4 * qb + (w >> 1);
    LAS unsigned char* lds = F.lds;
    bf16x8 qf1[2], qf2[2];
    { const bf16* qrow = P1h + (size_t)(b * SEQ + qb * 256 + w * 32 + r32) * 1024;
#pragma unroll
      for (int ks = 0; ks < 2; ++ks) { qf1[ks] = *(const GAS bf16x8*)(qrow + ks * 16 + hi * 8); qf2[ks] = *(const GAS bf16x8*)(qrow + 128 + ks * 16 + hi * 8); } }
    o1[0] = f32x16{}; o1[1] = f32x16{}; o2[0] = f32x16{}; o2[1] = f32x16{}; l1 = 0.f; l2 = 0.f; float m1 = -INFINITY, m2 = -INFINITY;
    const int which = tid >> 8, kp = tid & 255, krow = kp >> 2, kc = kp & 3, vrow = tid >> 3, vc = tid & 7;
    const unsigned koff = (unsigned)((256 + which * 128 + krow * 1024 + kc * 8) * 2), voff = (unsigned)((vrow * NTOK + vc * 8) * 2);
    constexpr bool VPM = ATT_FUSED != 0; constexpr int VPx = VPM ? 72 : L::VP, VBx = 64 * VPx * 2;
    const unsigned kdst = (unsigned)(which * 6144 + (krow * L::KP + kc * 8) * 2), vdst = (unsigned)((vrow * VPx + (VPM ? (vc >> 1) * 16 + (vc & 1) * 4 : vc * 8)) * 2);
    const char* const wsb = (const char*)F.ws;
    const unsigned kb32 = (unsigned)((const char*)P1h - wsb) + (unsigned)b * (unsigned)(SEQ * 2048), vb32 = (unsigned)((const char*)Vt - wsb) + (unsigned)b * (unsigned)(SEQ * 2);
    u32x4 kA, vA;
#define AD_LOAD(KR, VR, j) do { KR = *(const GAS u32x4*)(wsb + (size_t)(kb32 + (unsigned)(j) * (64u * 2048u) + koff)); VR = *(const GAS u32x4*)(wsb + (size_t)(vb32 + (unsigned)(j) * 128u + voff)); } while (0)
#define AD_WRITE(KR, VR, buf) do { *(LAS u32x4*)(lds + ATT_K_OFF + (buf) * 13312 + kdst) = KR; \
        { LAS u32x2* vp_ = (LAS u32x2*)(lds + ATT_V_OFF + (buf) * VBx + vdst); vp_[0] = (u32x2){VR.x, VR.y}; vp_[VPM ? 2 : 1] = (u32x2){VR.z, VR.w}; } } while (0)
#if ATT_FUSED
#define AD_STEP(j, buf) do { if ((j) <= myc) { f32x16 s0, s1, t0, t1; \
        attn_qk<32>(lds + ATT_K_OFF + (buf) * 13312, qf1, s0, s1, r32, hi); \
        attn_step_fused<32, true>(lds + ATT_K_OFF + (buf) * 13312 + 6144, qf2, t0, t1, s0, s1, lds + ATT_V_OFF + (buf) * VBx, o1, l1, m1, cscale, r32, hi);     \
        attn_step_fused<32, false>(lds, qf2, s0, s1, t0, t1, lds + ATT_V_OFF + (buf) * VBx, o2, l2, m2, cscale, r32, hi); } } while (0)
#else
#define AD_STEP(j, buf) do { if ((j) <= myc) { f32x16 s0, s1; \
        attn_qk<32>(lds + ATT_K_OFF + (buf) * 13312, qf1, s0, s1, r32, hi); \
        attn_sm_pv<32, false>(s0, s1, lds + ATT_V_OFF + (buf) * L::VBYTES, nullptr, o1, l1, m1, cscale, 0.f, false, 0, r32, hi); \
        attn_qk<32>(lds + ATT_K_OFF + (buf) * 13312 + 6144, qf2, s0, s1, r32, hi); \
        attn_sm_pv<32, false>(s0, s1, lds + ATT_V_OFF + (buf) * L::VBYTES, nullptr, o2, l2, m2, cscale, 0.f, false, 0, r32, hi); } } while (0)
#endif
    AD_LOAD(kA, vA, 0); AD_WRITE(kA, vA, 0);
    __syncthreads();
    if (w >= 4) __builtin_amdgcn_s_setprio(1);
    for (int j = 0; j < NT; j += 2) {
        AD_LOAD(kA, vA, j + 1);
        AD_STEP(j, 0);
        AD_WRITE(kA, vA, 1);
        __syncthreads();
        AD_LOAD(kA, vA, (j + 2 < NT) ? j + 2 : NT - 1);
        AD_STEP(j + 1, 1);
        if (j + 2 < NT) AD_WRITE(kA, vA, 0);
        __syncthreads();
    }
    __builtin_amdgcn_s_setprio(0);
#undef AD_LOAD
#undef AD_WRITE
#undef AD_STEP
}
DI void attn_store(bf16* orow, int hi, const f32x16 (&v)[2]) {
#pragma unroll
    for (int d = 0; d < 2; ++d)
#pragma unroll
        for (int g = 0; g < 4; ++g) { u32x2 w; w.x = cvtpk(v[d][4 * g], v[d][4 * g + 1]); w.y = cvtpk(v[d][4 * g + 2], v[d][4 * g + 3]); *(GAS u32x2*)(orow + 32 * d + 8 * g + 4 * hi) = w; }
}
constexpr int MS_K = 0, MS_V = 36864, MS_G = 71680, MS_RED = 0, MS_REDN = 65536;
DI void mlstm_state_unit(Frame& F, int bh, int blk) {
    const int b = bh / 6, h = bh % 6, lane = F.lane, r32 = lane & 31, hi = lane >> 5, w = F.wave, p = w >> 1, dh = w & 1, ptid = F.tid & 127, tl = 4 * blk + p;
    LAS unsigned char* lds = F.lds;
    const bf16* kbc = (const bf16*)(F.ws + WS_KBC) + (size_t)(b * SEQ + tl * 64) * 384 + h * 64;
    const bf16* vt = (const bf16*)(F.ws + WS_VTAB) + (size_t)(256 + h * 64) * NTOK + b * SEQ + tl * 64;
    const float* bt2 = (const float*)(F.ws + WS_BT2) + (size_t)bh * SEQ; const float* a2 = (const float*)(F.ws + WS_A2) + (size_t)bh * SEQ;
    { u32x4 kr[4], vr[4];
#pragma unroll
      for (int i = 0; i < 4; ++i) { const int q = ptid + 128 * i, row = q >> 3, c = q & 7; kr[i] = *(const GAS u32x4*)(kbc + (size_t)row * 384 + c * 8); vr[i] = *(const GAS u32x4*)(vt + (size_t)row * NTOK + c * 8); }
      const float g = (ptid < 64) ? a2[tl * 64 + ptid] : 0.f;
#pragma unroll
      for (int i = 0; i < 4; ++i) { const int q = ptid + 128 * i, row = q >> 3, c = q & 7;
          *(LAS u32x4*)(lds + MS_K + p * 9216 + (row * 72 + c * 8) * 2) = kr[i];
          LAS u32x2* vp = (LAS u32x2*)(lds + MS_V + p * 8704 + (row * 68 + c * 8) * 2); vp[0] = (u32x2){vr[i].x, vr[i].y}; vp[1] = (u32x2){vr[i].z, vr[i].w}; }
      if (ptid < 64) *(LAS float*)(lds + MS_G + p * 256 + ptid * 4) = g; }
    __syncthreads();
    bf16x8 qf[4]; const int col = 32 * dh + r32;
#pragma unroll
    for (int ks = 0; ks < 4; ++ks)
#pragma unroll
        for (int j = 0; j < 8; ++j) qf[ks][j] = (16 * ks + 8 * hi + j == col) ? (short)0x3F80 : (short)0;
    f32x16 s0, s1, o[2]; o[0] = f32x16{}; o[1] = f32x16{}; float lsum = 0.f, mrun = 0.f;
    attn_qk<64>(lds + MS_K + p * 9216, qf, s0, s1, r32, hi);
    attn_sm_pv<64, true>(s0, s1, lds + MS_V + p * 8704, (const LAS float*)(lds + MS_G + p * 256), o, lsum, mrun, 0.f, bt2[blk * 256 + 255], false, 0, r32, hi);
    lsum = half_swap_sum(lsum);
    __syncthreads();
    LAS float* red = (LAS float*)(lds + MS_RED) + p * 4096; LAS float* redn = (LAS float*)(lds + MS_REDN) + p * 64;
#pragma unroll
    for (int d = 0; d < 2; ++d)
#pragma unroll
        for (int r = 0; r < 16; ++r) red[(32 * d + (r & 3) + 8 * (r >> 2) + 4 * hi) * 64 + col] = o[d][r];
    if (hi == 0) redn[col] = lsum;
    __syncthreads();
    { const LAS f32x4* r4 = (const LAS f32x4*)(lds + MS_RED) + F.tid * 2; f32x4 a0 = r4[0], a1 = r4[1];
#pragma unroll
      for (int q = 1; q < 4; ++q) { a0 += r4[q * 1024]; a1 += r4[q * 1024 + 1]; }
      GAS f32x4* dc = (GAS f32x4*)((float*)(F.ws + WS_DC) + ((size_t)bh * 7 + blk) * 4096) + F.tid * 2; dc[0] = a0; dc[1] = a1;
      if (F.tid < 64) { const LAS float* rn = (const LAS float*)(lds + MS_REDN) + F.tid; ((float*)(F.ws + WS_DN))[((size_t)bh * 7 + blk) * 64 + F.tid] = (rn[0] + rn[64]) + (rn[128] + rn[192]); } }
    __syncthreads();
}
DI void mlstm_state_phase(Frame& F) { for (int u = F.cu; u < 96 * 7; u += F.G) mlstm_state_unit(F, u / 7, u % 7); }
constexpr int MS_CS = 65536, MS_NS = 65536 + 9216;
DI void mlstm_inter(Frame& F, int bh, int qb, const bf16* qrow  , float bt2q, f32x16 (&o)[2], float& den) {
    int lane = F.lane; asm volatile("" : "+v"(lane));
    const int r32 = lane & 31, hi = lane >> 5, tid = F.wave * 64 + lane;
    LAS unsigned char* lds = F.lds;
    const float* bt2 = (const float*)(F.ws + WS_BT2) + (size_t)bh * SEQ;
    const float bref = bt2[qb * 256 - 1];
    { const int dv = tid >> 3, dk0 = (tid & 7) * 8; f32x4 c0 = {0.f, 0.f, 0.f, 0.f}, c1 = c0; float nacc = 0.f;
      for (int b0 = 0; b0 < qb; b0 += 4) { float bend[4]; f32x4 d0[4], d1[4]; float dnv[4];
#pragma unroll
          for (int i = 0; i < 4; ++i) { const int blk = (b0 + i < qb) ? b0 + i : qb - 1;
              bend[i] = bt2[blk * 256 + 255];
              const GAS f32x4* dc = (const GAS f32x4*)((const float*)(F.ws + WS_DC) + ((size_t)bh * 7 + blk) * 4096 + dv * 64 + dk0); d0[i] = dc[0]; d1[i] = dc[1];
              dnv[i] = (tid < 64) ? ((const float*)(F.ws + WS_DN))[((size_t)bh * 7 + blk) * 64 + tid] : 0.f; }
#pragma unroll
          for (int i = 0; i < 4; ++i) { const float d = (b0 + i < qb) ? __builtin_amdgcn_exp2f(bref - bend[i]) : 0.f; c0 += d0[i] * d; c1 += d1[i] * d; nacc += dnv[i] * d; } }
      u32x4 wv; wv.x = cvtpk(c0.x, c0.y); wv.y = cvtpk(c0.z, c0.w); wv.z = cvtpk(c1.x, c1.y); wv.w = cvtpk(c1.z, c1.w);
      *(LAS u32x4*)(lds + MS_CS + (dv * 72 + dk0) * 2) = wv;
      if (tid < 64) *(LAS float*)(lds + MS_NS + tid * 4) = nacc; }
    __syncthreads();
    bf16x8 qf[4];
#pragma unroll
    for (int ks = 0; ks < 4; ++ks) qf[ks] = *(const GAS bf16x8*)(qrow + ks * 16 + hi * 8);
    f32x16 i0, i1; attn_qk<64>(lds + MS_CS, qf, i0, i1, r32, hi);
    float dn = 0.f;
#pragma unroll
    for (int ks = 0; ks < 4; ++ks) { const f32x4 n0 = *(const LAS f32x4*)(lds + MS_NS + (16 * ks + 8 * hi) * 4), n1 = *(const LAS f32x4*)(lds + MS_NS + (16 * ks + 8 * hi + 4) * 4);
#pragma unroll
        for (int j = 0; j < 4; ++j) dn += bf2f((unsigned short)qf[ks][j]) * n0[j] + bf2f((unsigned short)qf[ks][4 + j]) * n1[j]; }
    dn = half_swap_sum(dn);
    const float u = __builtin_amdgcn_exp2f(bt2q - bref);
#pragma unroll
    for (int r = 0; r < 16; ++r) { o[0][r] += u * i0[r]; o[1][r] += u * i1[r]; }
    den += u * dn;
}
DI void attn_unit(Frame& F, KArgs a, int l, int mode, int bh, int qb) {
    const bf16* P1 = (const bf16*)(F.ws + WS_P1); bf16* mix = (bf16*)(F.ws + WS_HB);
    const int lane = F.lane, r32 = lane & 31, hi = lane >> 5;
    f32x16 o[2]; float lsum;
    if (mode == 0) {
        const int b = bh >> 2, h = bh & 3; const size_t row = (size_t)b * SEQ + qb * 256 + F.wave * 32 + r32;
        const bf16* Vt = (const bf16*)(F.ws + WS_VTAB) + (size_t)(h * 64) * NTOK; const float cs = 0.17677669529663687f * LOG2E;
        f32x16 o1[2]; float lsum1;
        attn_pass_diff(F, P1 + h * 32, Vt, b, qb, cs, o1, lsum1, o, lsum);
        { const float inv = 1.f / half_swap_sum(lsum1);
#pragma unroll
          for (int d = 0; d < 2; ++d)
#pragma unroll
              for (int r = 0; r < 16; ++r) o1[d][r] *= inv; }
        float d1 = 0.f, d2 = 0.f;
        { const float* q1 = IN(I_LQ1) + l * 32, *k1 = IN(I_LK1) + l * 32, *q2 = IN(I_LQ2) + l * 32, *k2 = IN(I_LK2) + l * 32;
#pragma unroll 8
          for (int i = 0; i < 32; ++i) { d1 += q1[i] * k1[i]; d2 += q2[i] * k2[i]; } }
        const float lam_init = 0.8f - 0.6f * __expf(-0.3f * (float)l), lam = __expf(d1) - __expf(d2) + lam_init;
        const float inv2 = lam / half_swap_sum(lsum); float ss = 0.f;
#pragma unroll
        for (int d = 0; d < 2; ++d)
#pragma unroll
            for (int r = 0; r < 16; ++r) { o[d][r] = o1[d][r] - o[d][r] * inv2; ss += o[d][r] * o[d][r]; }
        const float rstd = rsqrtf(half_swap_sum(ss) * (1.f / 64.f) + EPS) * (1.f - lam_init); const float* gd = IN(I_GDIFF) + l * 64;
#pragma unroll
        for (int d = 0; d < 2; ++d)
#pragma unroll
            for (int g = 0; g < 4; ++g) { const f32x4 gg = *(const GAS f32x4*)(gd + 32 * d + 8 * g + 4 * hi);
#pragma unroll
                for (int q = 0; q < 4; ++q) o[d][4 * g + q] *= rstd * gg[q]; }
        attn_store(mix + row * D + h * 64, hi, o);
    } else if (mode == 1) {
        const int b = bh / 6, h = bh % 6; const size_t row = (size_t)b * SEQ + qb * 256 + F.wave * 32 + r32;
        const bf16* Vt = (const bf16*)(F.ws + WS_VTAB) + (size_t)(256 + h * 64) * NTOK;
        const float* bt2 = (const float*)(F.ws + WS_BT2) + (size_t)bh * SEQ; const float* a2 = (const float*)(F.ws + WS_A2) + (size_t)bh * SEQ;
        const float bt2q = bt2[qb * 256 + F.wave * 32 + r32];
        attn_pass<64, true>(F, (const bf16*)(F.ws + WS_QBC) + h * 64, 384, (const bf16*)(F.ws + WS_KBC) + h * 64, 384, Vt, a2, bt2q, b, qb, 0.f, o, lsum, 4 * qb);
        float den = half_swap_sum(lsum);
        if (qb > 0) mlstm_inter(F, bh, qb, (const bf16*)(F.ws + WS_QBC) + row * 384 + h * 64, bt2q, o, den);
        const float inv = 1.f / fmaxf(fabsf(den), 1.f); float ss = 0.f;
#pragma unroll
        for (int d = 0; d < 2; ++d)
#pragma unroll
            for (int r = 0; r < 16; ++r) { o[d][r] *= inv; ss += o[d][r] * o[d][r]; }
        const float rstd = rsqrtf(half_swap_sum(ss) * (1.f / 64.f) + EPS); const float* gm = IN(I_GML) + l * 384 + h * 64; const bf16* ob = P1 + row * 1024 + 512 + h * 64;
#pragma unroll
        for (int d = 0; d < 2; ++d)
#pragma unroll
            for (int g = 0; g < 4; ++g) { const int dv = 32 * d + 8 * g + 4 * hi; const f32x4 gg = *(const GAS f32x4*)(gm + dv); const u32x2 ow = *(const GAS u32x2*)(ob + dv);
                const float og[4] = {bflo(ow.x), bfhi(ow.x), bflo(ow.y), bfhi(ow.y)};
#pragma unroll
                for (int q = 0; q < 4; ++q) o[d][4 * g + q] *= rstd * gg[q] * sigmoidf_(og[q]); }
        attn_store(mix + row * D + 256 + h * 64, hi, o);
    } else {
        const int b = bh / 6, h = bh % 6; const size_t row = (size_t)b * SEQ + qb * 256 + F.wave * 32 + r32;
        const bf16* Vt = (const bf16*)(F.ws + WS_VTC) + (size_t)(h * 64) * NTOK;
        attn_pass<96, false>(F, (const bf16*)(F.ws + WS_QC) + h * 96, 576, (const bf16*)(F.ws + WS_KC) + h * 96, 576, Vt, nullptr, 0.f, b, qb, 0.10206207261596577f * LOG2E, o, lsum);
        const float inv = 1.f / half_swap_sum(lsum);
#pragma unroll
        for (int d = 0; d < 2; ++d)
#pragma unroll
            for (int r = 0; r < 16; ++r) o[d][r] *= inv;
        attn_store(mix + row * D + 640 + h * 64, hi, o);
    }
}
DI void phase_attn(Frame& F, KArgs a, int l, int rep = 0) {
    volatile LAS int* slot = (volatile LAS int*)(F.lds + MISC_OFF + 256);
    for (;;) {
        __syncthreads();
        if (F.tid == 0) slot[0] = (int)__hip_atomic_fetch_add((unsigned*)(F.ctl + CW_ATTQ + 64 * l + 16 * rep), 1u, __ATOMIC_RELAXED, __HIP_MEMORY_SCOPE_AGENT);
        __syncthreads();
        int i = slot[0];
        if (l == 0) {
            if (i >= 2048 + TR_MOE_CHUNKS) break;
            if (i < 4 * TR_MOE_CHUNKS) {
                if (i % 4 == 3) { const int c = i / 4;
                    tr_run(F, a, TR_N_EARLY + c * TR_MOE_CHUNK + F.wave, TR_N_EARLY + (c + 1) * TR_MOE_CHUNK, NWAVES, (LAS float*)(F.lds + F.wave * 16384));
                    continue; }
                i -= i / 4; }
            else i -= TR_MOE_CHUNKS; }
        if (i >= 2048) break;
        const int qb = 7 - (i >> 8), j = i & 255;
        if (j < 96) attn_unit(F, a, l, 2, j, qb); else if (j < 160) attn_unit(F, a, l, 0, j - 96, qb); else attn_unit(F, a, l, 1, j - 160, qb);
    }
}

constexpr int PH_LAYER0 = 2, PH_STRIDE = 20, N_PHASES = PH_LAYER0 + PH_STRIDE * DEPTH;
DI pg8::Job mkjob(const bf16* A, const bf16* Bt, int lda, int ldb, int K, int nM, int nN, int epi, bf16* O, int ldc) {
    pg8::Job J; J.A = A; J.Bt = Bt; J.lda = lda; J.ldb = ldb; J.K = K; J.nM = nM; J.nN = nN; J.sched = pg8::SCH_STATIC; J.rot = 0; J.epi = epi; J.O = O; J.ldc = ldc; J.row_limit = 0x7fffffff; J.split_cols = 0; J.split_stride = 0;
    J.cs = nullptr; J.glist = nullptr; J.gather = 0; J.tile0 = 0; J.bexp_rows = 0; return J;
}
DI bool phase_active(int p) {
    if (p < PH_LAYER0) return true;
    const int l = (p - PH_LAYER0) / PH_STRIDE, r = (p - PH_LAYER0) % PH_STRIDE;
    if (r <= 5 || r == 16) return true;
    if (r <= 7) return true;
    return (l & 1) && r < 6 + 2 * MOE_MAX_CHUNKS;
}
DI int phase_njobs(int p) {
    if (p < PH_LAYER0) return 0;
    const int l = (p - PH_LAYER0) / PH_STRIDE, r = (p - PH_LAYER0) % PH_STRIDE;
    if (r == 0) return 2; if (r == 2) return 3; if (r == 4) return 1;
    if (r >= 6 && r < 16) return 1;
    (void)l; return 0;
}
DI bool get_job(Frame& F, const LAS int* mm, int p, int jj, pg8::Job& J) {
    unsigned char* ws = F.ws; const bf16* HB = (const bf16*)(ws + WS_HB);
    const int l = (p - PH_LAYER0) / PH_STRIDE, r = (p - PH_LAYER0) % PH_STRIDE;
    if (r == 0) {
        if (jj == 0) { J = mkjob(HB, (const bf16*)(ws + WS_WIN) + (size_t)l * 2048 * 1024, 1024, 1024, 1024, NTOK / 256, 8, pg8::EPI_STORE, (bf16*)(ws + WS_P1), 1024); J.split_cols = 1024; J.split_stride = (long)((WS_P2 - WS_P1) / 2); }
        else { J = mkjob((const bf16*)(ws + WS_WV) + (size_t)l * 768 * 1024, HB, 1024, 1024, 1024, 3, NTOK / 256, pg8::EPI_STORE, (bf16*)(ws + WS_VTAB), NTOK); J.row_limit = 640; J.rot = 128; }
        return true; }
    if (r == 2) {
        if (jj == 0) { J = mkjob((const bf16*)(ws + WS_CQN), (const bf16*)(ws + WS_WUQ) + (size_t)l * 768 * 256, 256, 256, 256, NTOK / 256, 3, pg8::EPI_ROPEQ, (bf16*)(ws + WS_QC), 576); J.cs = (const float*)(ws + WS_CS); }
        else if (jj == 1) { J = mkjob((const bf16*)(ws + WS_CKVN), (const bf16*)(ws + WS_WUKK) + (size_t)l * 512 * 128, 128, 128, 128, NTOK / 256, 2, pg8::EPI_KNOPE, (bf16*)(ws + WS_KC), 576); J.rot = 128; }
        else { J = mkjob((const bf16*)(ws + WS_WUKV) + (size_t)l * 512 * 128, (const bf16*)(ws + WS_CKVN), 128, 128, 128, 2, NTOK / 256, pg8::EPI_STORE, (bf16*)(ws + WS_VTC), NTOK); J.row_limit = 384; }
        return true; }
    if (r == 4) { J = mkjob(HB, (const bf16*)(ws + WS_WOUT) + (size_t)l * D * D, 1024, 1024, 1024, NTOK / 256, 4, pg8::EPI_STORE, (bf16*)(ws + WS_Y), 1024); return true; }
    if (!(l & 1)) {
#if DENSE_FP8 == 2
        if (r == 6) { J = mkjob((const bf16*)(ws + WS_H8), (const bf16*)(ws + WS_WGUD), 1024, 1024, 1024, NTOK / 256, 28, pg8::EPI_SWIGLU, (bf16*)(ws + WS_ACT), DFF); J.gather = 8; }
        else J = mkjob((const bf16*)(ws + WS_ACT), (const bf16*)(ws + WS_WDD), DFF, DFF, DFF, NTOK / 256, 4, pg8::EPI_STORE, (bf16*)(ws + WS_Y2), 1024);
#elif DENSE_FP8
        if (r == 6) J = mkjob((const bf16*)(ws + WS_H8), (const bf16*)(ws + WS_WGUD), 1024, 1024, 1024, NTOK / 256, 28, pg8::EPI_SWIGLU8, (bf16*)(ws + WS_ACT), DFF);
        else { J = mkjob((const bf16*)(ws + WS_ACT), (const bf16*)(ws + WS_WDD), DFF, DFF, DFF, NTOK / 256, 4, pg8::EPI_STORE, (bf16*)(ws + WS_Y2), 1024); J.gather = 8; }
#else
        if (r == 6) J = mkjob(HB, (const bf16*)(ws + WS_WGUD), 1024, 1024, 1024, NTOK / 256, 28, pg8::EPI_SWIGLU, (bf16*)(ws + WS_ACT), DFF);
        else J = mkjob((const bf16*)(ws + WS_ACT), (const bf16*)(ws + WS_WDD), DFF, DFF, DFF, NTOK / 256, 4, pg8::EPI_STORE, (bf16*)(ws + WS_Y2), 1024);
#endif
        return true; }
    const int c = (r - 6) >> 1; const bool up = !((r - 6) & 1);
    __syncthreads();
    if (F.tid < 8) { LAS int* mw = (LAS int*)mm;
        const int cnt = (int)__hip_atomic_load((unsigned*)(F.ctl + CW_MOECNT + F.tid), __ATOMIC_RELAXED, __HIP_MEMORY_SCOPE_AGENT);
        const int tiles = (cnt + 255) >> 8; int incl = tiles;
#pragma unroll
        for (int o = 1; o < 8; o <<= 1) { const int t = __builtin_amdgcn_ds_bpermute((F.tid - o) << 2, incl); if (F.tid >= o) incl += t; }
        mw[F.tid] = incl - tiles; mw[9 + F.tid] = cnt; if (F.tid == 7) mw[8] = incl; }
    __syncthreads();
    const int total = mm[8]; const int t0 = c * MOE_CHUNK_TILES; int nt = total - t0; if (nt > MOE_CHUNK_TILES) nt = MOE_CHUNK_TILES;
    if (nt <= 0) return false;
    if (up) { J = mkjob((const bf16*)(ws + WS_H8), (const bf16*)(ws + WS_WGUE), 1024, 1024, 1024, nt, 28, pg8::EPI_SWIGLU8, (bf16*)(ws + WS_ACT), DFF); J.gather = 1; J.bexp_rows = 7168; }
    else { J = mkjob((const bf16*)(ws + WS_ACT), (const bf16*)(ws + WS_WDE), DFF, DFF, DFF, nt, 4, pg8::EPI_SCATTER, (bf16*)(ws + WS_YM), 1024); J.bexp_rows = 1024; J.cs = (const float*)(ws + WS_DC); }
    J.sched = pg8::SCH_MOE; J.glist = (const int*)(ws + WS_LIST); J.tile0 = t0;
    return true;
}
#ifndef DBG_MASK
#define DBG_MASK 0xffff
#endif
#define DBG_ON(k) ((DBG_MASK >> (k)) & 1)
template <int KIND> DI void run_phase(Frame& F, KArgs a, int p, int rep, const XcdBarrier& bar, int wave0) {
    LAS int* mm = (LAS int*)(F.lds + MISC_OFF + 512);
    const int nj = phase_njobs(p);
    if constexpr (KIND == -1) { if (p >= PH_LAYER0 && (p - PH_LAYER0) % PH_STRIDE == 2) { RELANE(F); mlstm_state_phase(F); } }
    if (nj > 0) {
        if constexpr (KIND == -1 || KIND >= 10) {
            for (int jj = 0; jj < nj; ++jj) { pg8::Job J; RELANE(F);
                if (get_job(F, mm, p, jj, J)) {
                if (J.epi == pg8::EPI_STORE) { if (J.gather == 8) { if constexpr (DENSE_FP8 == 1 && (KIND == -1 || KIND == 16)) pg8::gemm_phase<pg8::EPI_STORE, false, true>(F.lds, mm, J, F.G, (int)blockIdx.x, F.wave);     }
                                               else { if constexpr (KIND == -1 || KIND == 10) pg8::gemm_phase<pg8::EPI_STORE, false>(F.lds, mm, J, F.G, (int)blockIdx.x, F.wave);     } }
                else if (J.epi == pg8::EPI_ROPEQ) { if constexpr (KIND == -1 || KIND == 11) pg8::gemm_phase<pg8::EPI_ROPEQ, false>(F.lds, mm, J, F.G, (int)blockIdx.x, F.wave);     }
                else if (J.epi == pg8::EPI_KNOPE) { if constexpr (KIND == -1 || KIND == 12) pg8::gemm_phase<pg8::EPI_KNOPE, false>(F.lds, mm, J, F.G, (int)blockIdx.x, F.wave);     }
                else if (J.epi == pg8::EPI_SWIGLU8) { if (J.sched == pg8::SCH_MOE) { if constexpr (KIND == -1 || KIND == 14) pg8::gemm_phase<pg8::EPI_SWIGLU8, true, true>(F.lds, mm, J, F.G, (int)blockIdx.x, F.wave);     }
                                                      else { if constexpr (DENSE_FP8 == 1 && (KIND == -1 || KIND == 13)) pg8::gemm_phase<pg8::EPI_SWIGLU8, false, true>(F.lds, mm, J, F.G, (int)blockIdx.x, F.wave);     } }
                else if (J.epi == pg8::EPI_SWIGLU && J.gather == 8) { if constexpr (DENSE_FP8 == 2 && (KIND == -1 || KIND == 13)) pg8::gemm_phase<pg8::EPI_SWIGLU, false, true>(F.lds, mm, J, F.G, (int)blockIdx.x, F.wave); }
                else if (J.epi == pg8::EPI_SWIGLU) { if constexpr (!DENSE_FP8 && (KIND == -1 || KIND == 13)) pg8::gemm_phase<pg8::EPI_SWIGLU, false>(F.lds, mm, J, F.G, (int)blockIdx.x, F.wave);     }
                else { if constexpr (KIND == -1 || KIND == 15) pg8::gemm_phase<pg8::EPI_SCATTER, true, true>(F.lds, mm, J, F.G, (int)blockIdx.x, F.wave);     } } } }
        if constexpr (KIND == -1) { if (p == PH_LAYER0 && F.G == 256 && (int)blockIdx.x < 128) {
            RELANE(F); __syncthreads(); tr_run(F, a, TR_N_SMALL + (int)blockIdx.x * NWAVES + F.wave, TR_N_EARLY, 128 * NWAVES, (LAS float*)(F.lds + F.wave * 16384)); } }
        return; }
    if (p == 0) { if constexpr (KIND == -1 || KIND == 0) { RELANE(F); p0_prologue(F, a); } return; }
    if (p == 1) { if constexpr (KIND == -1 || KIND == 1) { RELANE(F); phase_row0(F, a); } return; }
    const int l = (p - PH_LAYER0) / PH_STRIDE, r = (p - PH_LAYER0) % PH_STRIDE;
    if (r == 1) { if constexpr (KIND == -1 || KIND == 2) { RELANE(F); phase_fix(F, a, l);
        } }
    else if (r == 3) { if constexpr (KIND == -1 || KIND == 3) { RELANE(F); phase_attn(F, a, l, rep); } }
    else if (r == 5) { if constexpr (KIND == -1 || KIND == 4) { RELANE(F); phase_row1(F, a, l); } }
    else if (r == 16) { if constexpr (KIND == -1 || KIND == 5) { RELANE(F); phase_row2(F, a, l); } }
}

template <int KIND> __global__ void __launch_bounds__(NTHR, 2) mk_fwd(Args args) {
    extern __shared__ __attribute__((aligned(16))) unsigned char lds[];
    KArgs ka = (KArgs)__builtin_amdgcn_kernarg_segment_ptr();
    Frame F;
    F.lds = (LAS unsigned char*)lds; F.MISC = (volatile LAS unsigned*)(F.lds + MISC_OFF);
    F.tid = threadIdx.x; F.lane = F.tid & 63; F.wave = __builtin_amdgcn_readfirstlane(F.tid >> 6);
    F.G = gridDim.x; { const int bx = blockIdx.x; F.cu = (F.G % 8 == 0) ? (bx % 8) * (F.G / 8) + bx / 8 : bx; }
    F.ws = ka->ws; F.out = ka->out; F.ctl = (gu32*)(F.ws + WS_CTL);
    for (int u = F.tid; u < (LDS_BYTES - MISC_OFF) / 4; u += NTHR) ((LAS unsigned*)(F.lds + MISC_OFF))[u] = 0u;
    __syncthreads();
    if constexpr (KIND == -1) {
        XcdBarrier bar = xcd_barrier_post((unsigned*)(F.ctl + CW_BAR), F.MISC + 8, F.tid == 0);
        const int wave0 = F.wave;
        const int lo = ka->ph_lo, hi = ka->ph_hi;
        for (int p = lo; p < hi; ++p) {
            if (!phase_active(p)) continue;
            { int wv = wave0; asm volatile("" : "+s"(wv)); F.wave = wv; RELANE(F);
              KArgs k2 = ka; asm volatile("" : "+s"(k2)); F.ws = k2->ws; F.out = k2->out; F.ctl = (gu32*)(F.ws + WS_CTL);
              run_phase<-1>(F, k2, p, 0, bar, wave0); }
            xcd_barrier(bar, wave0);
#ifdef EXTRA_BAR
            xcd_barrier(bar, wave0);
#endif
#ifdef REP_MASK
            { const int r_ = (p - PH_LAYER0) % PH_STRIDE, l_ = (p - PH_LAYER0) / PH_STRIDE; int cls = -1;
              if (p == 0) cls = 0; else if (p >= PH_LAYER0) { if (r_ == 0) cls = 1; else if (r_ == 1) cls = 2; else if (r_ == 2) cls = 3; else if (r_ == 3) cls = 4; else if (r_ == 4) cls = 5;
                  else if (r_ >= 6 && r_ < 16) cls = (l_ & 1) ? 7 : 6; }
              if (cls >= 0 && ((REP_MASK >> cls) & 1)) { KArgs k3 = ka; asm volatile("" : "+s"(k3)); run_phase<-1>(F, k3, p, 1, bar, wave0); xcd_barrier(bar, wave0); } }
#endif
        }
    } else {
        { XcdBarrier nb; nb.bar = nullptr; nb.x = 0; nb.st = nullptr; run_phase<KIND>(F, ka, ka->ph_lo, 0, nb, 0); }
    }
    (void)args;
}
#if MK_SINGLE
#define MK_KERNELS(X) X(-1)
#else
#define MK_KERNELS(X) X(0) X(1) X(2) X(3) X(4) X(5) X(10) X(11) X(12) X(13) X(14) X(15)
#endif
static int phase_kinds(int p, int* kinds) {
    if (p == 0) { kinds[0] = 0; return 1; } if (p == 1) { kinds[0] = 1; return 1; }
    const int l = (p - PH_LAYER0) / PH_STRIDE, r = (p - PH_LAYER0) % PH_STRIDE;
    if (r == 0) { kinds[0] = 10; return 1; } if (r == 1) { kinds[0] = 2; return 1; } if (r == 2) { kinds[0] = 11; kinds[1] = 12; kinds[2] = 10; return 3; }
    if (r == 3) { kinds[0] = 3; return 1; } if (r == 4) { kinds[0] = 10; return 1; } if (r == 5) { kinds[0] = 4; return 1; } if (r == 16) { kinds[0] = 5; return 1; }
    if (!(l & 1)) { if (r == 6) { kinds[0] = 13; return 1; } if (r == 7) { kinds[0] = 10; return 1; } return 0; }
    if (r >= 6 && r < 16) { kinds[0] = ((r - 6) & 1) ? 15 : 14; return 1; }
    return 0;
}
template <int KIND> static void launch_kind(int grid, hipStream_t stream, const Args& a) { hipLaunchKernelGGL(mk_fwd<KIND>, dim3(grid), dim3(NTHR), LDS_BYTES, stream, a); }
template <int KIND> static bool set_attr() { return hipFuncSetAttribute((const void*)mk_fwd<KIND>, hipFuncAttributeMaxDynamicSharedMemorySize, LDS_BYTES) == hipSuccess; }

extern "C" void kernel_launch(void* const* d_in, const int* in_sizes, int n_in, void* d_out, int out_size, void* d_ws, size_t ws_size, hipStream_t stream) {
    static int grid = 0;
    if (grid == 0) {
        if (n_in != 30 || out_size != NTOK * D || ws_size < WS_END) { fprintf(stderr, "kernel_launch: unexpected shapes (n_in %d out %d ws %zu)\n", n_in, out_size, ws_size); grid = -1; return; }
        int dev = 0, cus = 0;
        if (hipGetDevice(&dev) != hipSuccess || hipDeviceGetAttribute(&cus, hipDeviceAttributeMultiprocessorCount, dev) != hipSuccess) { grid = -1; return; }
        bool ok = true;
#define X(k) ok = ok && set_attr<k>();
        MK_KERNELS(X)
#undef X
        if (!ok) { fprintf(stderr, "kernel_launch: hipFuncSetAttribute failed\n"); grid = -1; return; }
        (void)hipGetLastError();
        grid = cus;
    }
    if (grid < 0) return;
    (void)hipMemsetAsync((char*)d_ws + WS_CTL, 0, CTL_ZERO_BYTES, stream);
    Args a{};
    for (int i = 0; i < 30; ++i) a.in[i] = d_in[i];
    a.out = (float*)d_out; a.ws = (unsigned char*)d_ws;
#if MK_SINGLE
    a.ph_lo = 0; a.ph_hi = N_PHASES;
    launch_kind<-1>(grid, stream, a);
#else
    for (int p = 0; p < N_PHASES; ++p) {
        int kinds[4]; const int nk = phase_kinds(p, kinds);
        a.ph_lo = p; a.ph_hi = p + 1;
        for (int i = 0; i < nk; ++i) {
            switch (kinds[i]) {
#define X(k) case k: launch_kind<k>(grid, stream, a); break;
                MK_KERNELS(X)
#undef X
            }
        }
    }
#endif
}
```

```cpp
#include <hip/hip_runtime.h>
#include <cstdio>
#include <cstdint>

#ifndef MK_SINGLE
#ifndef ATT_FUSED
#define ATT_FUSED 1
#endif
#ifndef ATT_CINIT
#define ATT_CINIT 1
#endif
#define MLA_QSCALE_ON (ATT_FUSED && ATT_CINIT)
#define ATT_CINIT 0
#define MK_SINGLE 1
#endif

#define GAS __attribute__((address_space(1)))
#define LAS __attribute__((address_space(3)))
#define DI __device__ __forceinline__
typedef unsigned short bf16;
typedef short bf16x8 __attribute__((ext_vector_type(8)));
typedef short s16x4 __attribute__((ext_vector_type(4)));
typedef float f32x2 __attribute__((ext_vector_type(2)));
typedef float f32x4 __attribute__((ext_vector_type(4)));
typedef float f32x16 __attribute__((ext_vector_type(16)));
typedef unsigned u32x2 __attribute__((ext_vector_type(2)));
typedef unsigned u32x4 __attribute__((ext_vector_type(4)));
typedef int i32x8 __attribute__((ext_vector_type(8)));
typedef short s16x16 __attribute__((ext_vector_type(16)));
typedef __bf16 bf16x2_t __attribute__((ext_vector_type(2)));
typedef GAS unsigned gu32;

constexpr int D = 1024, BATCH = 16, SEQ = 2048, NTOK = BATCH * SEQ, DEPTH = 2;
constexpr int INW = 2668, DFF = 3584, NEXP = 8;
constexpr float EPS = 1e-6f;
constexpr int NWAVES = 8, NTHR = 512;
constexpr float LOG2E = 1.4426950408889634f;
constexpr float MLA_QSCALE = MLA_QSCALE_ON ? 0.10206207261596577f * 1.4426950408889634f : 1.f;

constexpr size_t MiB = 1u << 20;
constexpr size_t WS_CTL = 0, CTL_ZERO_BYTES = 32768;
constexpr size_t WS_MOD = 1 * MiB;
constexpr size_t WS_CS = 2 * MiB;
constexpr size_t WS_BT2 = 6 * MiB;
constexpr size_t WS_A2 = WS_BT2 + 768 * 1024;
constexpr size_t WS_GATE = 7 * MiB + 768 * 1024;
constexpr size_t WS_LIST = 8 * MiB;
constexpr size_t WS_WIN = 9 * MiB;
constexpr size_t WS_WV = WS_WIN + 8 * MiB;
constexpr size_t WS_WOUT = WS_WV + 3 * MiB;
constexpr size_t WS_WUQ = WS_WOUT + 4 * MiB;
constexpr size_t WS_WUKK = WS_WUQ + 768 * 1024;
constexpr size_t WS_WUKV = WS_WUKK + 256 * 1024;
constexpr size_t WS_WGUD = WS_WUKV + 256 * 1024;
constexpr size_t WS_WDD = WS_WGUD + 14 * MiB;
constexpr size_t WS_WGUE = WS_WDD + 7 * MiB;
constexpr size_t WS_WDE = WS_WGUE + 56 * MiB;
constexpr size_t WS_XB = WS_WDE + 28 * MiB;
constexpr size_t WS_DC = WS_XB + 64 * MiB;
constexpr size_t WS_DN = WS_DC + 10752 * 1024;
constexpr size_t WS_ACT0 = 215 * MiB;
static_assert(WS_DN + 172032 <= WS_ACT0, "weights");
constexpr size_t WS_HB = WS_ACT0;
constexpr size_t WS_CQN = WS_HB;
constexpr size_t WS_CKVN = WS_HB + 16 * MiB;
constexpr size_t WS_P1 = WS_HB + 64 * MiB;
constexpr size_t WS_P2 = WS_P1 + 64 * MiB;
constexpr size_t WS_VTC = WS_P2;
constexpr size_t WS_Y = WS_P1;
constexpr size_t WS_VTAB = WS_P2 + 64 * MiB;
constexpr size_t WS_QBC = WS_VTAB + 40 * MiB;
constexpr size_t WS_KBC = WS_QBC + 24 * MiB;
constexpr size_t WS_QC = WS_KBC + 24 * MiB;
constexpr size_t WS_KC = WS_QC + 36 * MiB;
constexpr size_t WS_END = WS_KC + 36 * MiB;
constexpr size_t WS_ACT = WS_P1;
#ifndef DENSE_FP8
#define DENSE_FP8 2
#endif
constexpr size_t WS_Y2 = WS_ACT + (DENSE_FP8 == 1 ? 112 : 224) * MiB;
constexpr size_t WS_YM = WS_ACT + 112 * MiB;
constexpr size_t WS_H8 = WS_YM + 128 * MiB;
static_assert(WS_Y2 + 64 * MiB <= WS_END && WS_H8 + 32 * MiB <= WS_END && (DENSE_FP8 != 1 || WS_Y2 + 64 * MiB <= WS_H8), "ffn overlay");
static_assert(WS_END <= 594600000ull, "workspace");
constexpr int CW_BAR = 4096;
constexpr int CW_ATTQ = 64;
constexpr int CW_MOECNT = 256;
constexpr int MOE_CHUNK_TILES = 128, MOE_MAX_CHUNKS = 3;

constexpr int RING_BYTES = 131072;
constexpr int MISC_OFF = RING_BYTES;
constexpr int LDS_BYTES = 147456;

DI unsigned cvtpk(float lo, float hi) { f32x2 v = {lo, hi}; bf16x2_t b = __builtin_convertvector(v, bf16x2_t); return __builtin_bit_cast(unsigned, b); }
DI unsigned pk4_fp8(float a, float b, float c, float d) { int p = __builtin_amdgcn_cvt_pk_fp8_f32(a, b, 0, false); p = __builtin_amdgcn_cvt_pk_fp8_f32(c, d, p, true); return (unsigned)p; }
DI float bf2f(unsigned short b) { return __builtin_bit_cast(float, (unsigned)b << 16); }
DI float bflo(unsigned w) { return __builtin_bit_cast(float, w << 16); }
DI float bfhi(unsigned w) { return __builtin_bit_cast(float, w & 0xffff0000u); }
DI float lane_read(float v, int src_lane) { return __builtin_bit_cast(float, __builtin_amdgcn_ds_bpermute(src_lane << 2, __builtin_bit_cast(int, v))); }
template <int CTRL, int RM> DI float dpp_mov_(float v) { return __builtin_bit_cast(float, __builtin_amdgcn_update_dpp(0, __builtin_bit_cast(int, v), CTRL, RM, 0xf, false)); }
#define DPP_SUM_STEPS(v) do { v += dpp_mov_<0xB1, 0xf>(v); v += dpp_mov_<0x4E, 0xf>(v); v += dpp_mov_<0x141, 0xf>(v); v += dpp_mov_<0x140, 0xf>(v);   \
        v += dpp_mov_<0x142, 0xa>(v); v += dpp_mov_<0x143, 0xc>(v); } while (0)
DI float wave_sum(float v, int lane) { (void)lane; DPP_SUM_STEPS(v); return __builtin_bit_cast(float, __builtin_amdgcn_readlane(__builtin_bit_cast(int, v), 63)); }
DI void wave_sum2(float& a, float& b, int lane) { (void)lane; DPP_SUM_STEPS(a); DPP_SUM_STEPS(b);
    a = __builtin_bit_cast(float, __builtin_amdgcn_readlane(__builtin_bit_cast(int, a), 63)); b = __builtin_bit_cast(float, __builtin_amdgcn_readlane(__builtin_bit_cast(int, b), 63)); }
DI float half_swap_sum(float v) { auto rr = __builtin_amdgcn_permlane32_swap(__float_as_uint(v), __float_as_uint(v), false, false); return __uint_as_float(rr[0]) + __uint_as_float(rr[1]); }
DI float half_swap_max(float v) { auto rr = __builtin_amdgcn_permlane32_swap(__float_as_uint(v), __float_as_uint(v), false, false); return fmaxf(__uint_as_float(rr[0]), __uint_as_float(rr[1])); }
DI float siluf(float x) { return x * __builtin_amdgcn_rcpf(1.f + __builtin_amdgcn_exp2f(x * -1.4426950408889634f)); }
DI float sigmoidf_(float x) { return __builtin_amdgcn_rcpf(1.f + __builtin_amdgcn_exp2f(x * -1.4426950408889634f)); }
#define LDS_WAIT() asm volatile("s_waitcnt lgkmcnt(0)" ::: "memory")
#define VM_WAIT() asm volatile("s_waitcnt vmcnt(0)" ::: "memory")

#define XB_TMO      128
#define XB_XCNT(j)  (256  + 64 * (j))
#define XB_XSUB(j)  (1280 + 64 * (j))
#define XB_XGEN(j)  (2304 + 64 * (j))
#define XB_TOP      3328
#define XB_TOPGEN   3392
#define XCD_BAR_WORDS 3456
#define XB_SPIN_CAP (1u << 22)
DI unsigned xb_ld(unsigned* p)              { return __hip_atomic_load(p, __ATOMIC_RELAXED, __HIP_MEMORY_SCOPE_AGENT); }
DI unsigned xb_add(unsigned* p, unsigned v) { return __hip_atomic_fetch_add(p, v, __ATOMIC_RELAXED, __HIP_MEMORY_SCOPE_AGENT); }
DI unsigned xb_xcc_id() { return (unsigned)__builtin_amdgcn_s_getreg((3 << 11) | 20) & 0xFu; }
#define XB_SPIN(cond, bar) do { unsigned _sp = 0; while (cond) { __builtin_amdgcn_s_sleep(1); \
    if ((++_sp & 255u) == 0u) { if (xb_ld(&(bar)[XB_TMO])) break; if (_sp > XB_SPIN_CAP) { atomicAdd(&(bar)[XB_TMO], 1u); break; } } } } while (0)
struct XcdBarrier { unsigned* bar; unsigned x; volatile LAS unsigned* st; };
DI XcdBarrier xcd_barrier_post(unsigned* bar, volatile LAS unsigned* st, bool leader) {
    XcdBarrier b; b.bar = bar; b.x = xb_xcc_id(); b.st = st;
    if (leader) (void)xb_add(&bar[XB_XCNT(b.x)], 1u);
    return b;
}
DI void xcd_barrier_complete(unsigned* bar, unsigned x, unsigned& nloc, unsigned& nx) {
    const unsigned G = gridDim.x * gridDim.y * gridDim.z;
    unsigned sum, cnt, mine, sp = 0u;
    for (;;) {
        sum = 0u; cnt = 0u; mine = 0u;
#pragma unroll
        for (unsigned j = 0; j < 16; ++j) { const unsigned c = xb_ld(&bar[XB_XCNT(j)]); sum += c; cnt += (c > 0u) ? 1u : 0u; mine = (j == x) ? c : mine; }
        if (sum == G) break;
        __builtin_amdgcn_s_sleep(1);
        if ((++sp & 255u) == 0u) { if (xb_ld(&bar[XB_TMO])) break; if (sp > XB_SPIN_CAP) { atomicAdd(&bar[XB_TMO], 1u); break; } }
    }
    nloc = mine > 0u ? mine : 1u; nx = cnt > 0u ? cnt : 1u;
}
DI void xcd_barrier(const XcdBarrier& b, int wave_id) {
    int ln_; asm volatile("v_mbcnt_lo_u32_b32 %0, -1, 0\n\tv_mbcnt_hi_u32_b32 %0, -1, %0" : "=v"(ln_)); const bool leader = (wave_id == 0) && (ln_ == 0);
    asm volatile("s_waitcnt vmcnt(0)" ::: "memory");
    __syncthreads();
    if (leader) {
        unsigned* bar = b.bar;
        __builtin_amdgcn_s_waitcnt(0);
        unsigned nloc = b.st[0], nx = b.st[1];
        if (nloc == 0u) { xcd_barrier_complete(bar, b.x, nloc, nx); b.st[0] = nloc; b.st[1] = nx; }
        const unsigned old = xb_add(&bar[XB_XSUB(b.x)], 1u);
        const unsigned gen = old / nloc;
        if (old + 1u == (gen + 1u) * nloc) {
            __builtin_amdgcn_fence(__ATOMIC_RELEASE, "agent");
            asm volatile("s_waitcnt vmcnt(0)" ::: "memory");
            const unsigned og = xb_add(&bar[XB_TOP], 1u);
            const unsigned tg = og / nx;
            if (og + 1u == (tg + 1u) * nx) xb_add(&bar[XB_TOPGEN], 1u);
            else XB_SPIN(xb_ld(&bar[XB_TOPGEN]) == tg, bar);
            __builtin_amdgcn_fence(__ATOMIC_ACQUIRE, "agent");
            xb_add(&bar[XB_XGEN(b.x)], 1u);
            asm volatile("s_waitcnt vmcnt(0)" ::: "memory");
        } else {
            XB_SPIN(xb_ld(&bar[XB_XGEN(b.x)]) == gen, bar);
            __builtin_amdgcn_fence(__ATOMIC_ACQUIRE, "agent");
            asm volatile("s_waitcnt vmcnt(0)" ::: "memory");
        }
    }
    __syncthreads();
}

namespace pg8 {
constexpr int BM = 256, BK = 64, HALF = 128, HTB = HALF * BK * 2, STAGE_BYTES = 8 * HTB, NXCD = 8, WGM = 8;
__host__ __device__ __forceinline__ int lds_byte(int r, int c) { const int st = (r >> 4) * 2 + (c >> 5), rr = r & 15, cc = c & 31, ob = rr * 64 + cc * 2; return st * 1024 + (ob ^ (((ob >> 9) & 1) << 5)); }
__host__ __device__ __forceinline__ void stage_rc(int b, int& R, int& C) { const int st = b / 1024, sb = b % 1024, swz = sb ^ (((sb >> 9) & 1) << 5); R = (st >> 1) * 16 + swz / 64; C = (st & 1) * 32 + (swz % 64) / 2; }
__host__ __device__ __forceinline__ int perm32(int rho) { const int n = rho >> 4, i = rho & 15; return 8 * (i >> 2) + 4 * n + (i & 3); }

struct Unit { int pm, pn; int arow; int brow; int lidx; int nvalid; };
enum { EPI_STORE = 0, EPI_ROPEQ = 1, EPI_KNOPE = 2, EPI_SWIGLU = 3, EPI_SCATTER = 4, EPI_SWIGLU8 = 5 };
enum { SCH_STATIC = 0, SCH_MOE = 1 };
struct Job {
    const bf16* A; const bf16* Bt; int lda, ldb, K;
    int nM, nN;
    int sched, rot;
    int epi;
    bf16* O; int ldc; int row_limit; int split_cols; long split_stride;
    const float* cs;
    const int* glist;
    int gather;
    int tile0;
    int bexp_rows;
};
struct MoeMeta { int pref[9]; int cnt[8]; };

template <bool MOE> DI bool sched_next(const Job& J, const LAS int* mm  , int i, int G, int c, Unit& u) {
    const int nwg = J.nM * J.nN;
    const long L = (long)i * G + ((c + J.rot) % G); if (L >= nwg) return false;
    int wgid = (int)L; { const int q = nwg / NXCD, r = nwg % NXCD, xcd = wgid % NXCD, off = wgid / NXCD; wgid = (xcd < r ? xcd * (q + 1) : r * (q + 1) + (xcd - r) * q) + off; }
    const int nig = WGM * J.nN, gid = wgid / nig, fm = gid * WGM, gsz = (J.nM - fm) < WGM ? (J.nM - fm) : WGM;
    u.pm = fm + ((wgid % nig) % gsz); u.pn = (wgid % nig) / gsz;
    u.arow = u.pm * BM; u.brow = u.pn * BM; u.lidx = 0; u.nvalid = BM;
    if constexpr (MOE) {
        const int tg = J.tile0 + u.pm; int e = 0;
#pragma unroll
        for (int k = 1; k < 8; ++k) e += (tg >= mm[k]) ? 1 : 0;
        const int t = tg - mm[e];
        u.lidx = e * 32768 + t * 256; const int rem = mm[9 + e] - t * 256; u.nvalid = rem < 256 ? rem : 256;
        u.brow = e * J.bexp_rows + u.pn * BM;
    }
    return true;
}

template <int EPI> DI void epilogue(const Job& J, const f32x4 (&acc)[2][2][4][2], const Unit& u, int wr, int wc, int fr_, int fq_) {
    int ln_; asm volatile("v_mbcnt_lo_u32_b32 %0, -1, 0\n\tv_mbcnt_hi_u32_b32 %0, -1, %0" : "=v"(ln_));
    const int fr = ln_ & 15, fq = ln_ >> 4; (void)fr_; (void)fq_;
    const int rloc0 = wr * 64 + fr;
    const int cloc0 = wc * 32 + 8 * fq;
    if constexpr (EPI == EPI_STORE) {
        int colt = u.pn * BM; bf16* base = J.O;
        if (J.split_cols) { const int t = colt / J.split_cols; base += (long)t * J.split_stride; colt -= t * J.split_cols; }
#pragma unroll
        for (int ai = 0; ai < 2; ++ai)
#pragma unroll
            for (int m = 0; m < 4; ++m) { const int row = u.pm * BM + rloc0 + ai * HALF + m * 16;
                if (row < J.row_limit) { bf16* rowp = base + (size_t)row * J.ldc + colt + cloc0;
#pragma unroll
                    for (int bj = 0; bj < 2; ++bj) { const f32x4 v0 = acc[ai][bj][m][0], v1 = acc[ai][bj][m][1]; u32x4 w; w.x = cvtpk(v0[0], v0[1]); w.y = cvtpk(v0[2], v0[3]); w.z = cvtpk(v1[0], v1[1]); w.w = cvtpk(v1[2], v1[3]);
                        *(u32x4*)(rowp + bj * HALF) = w; } } }
    } else if constexpr (EPI == EPI_ROPEQ) {
#pragma unroll
        for (int bj = 0; bj < 2; ++bj) { const int col = u.pn * BM + bj * HALF + cloc0;
            if (col < 576) { const int d = col % 96; const bool rp = d >= 64; const int g4 = rp ? (d - 64) >> 1 : 0;
                f32x4 csv[2][4], snv[2][4];
#pragma unroll
                for (int ai = 0; ai < 2; ++ai)
#pragma unroll
                    for (int m = 0; m < 4; ++m) { const int row = u.pm * BM + rloc0 + ai * HALF + m * 16; csv[ai][m] = *(const f32x4*)(J.cs + (size_t)row * 32 + g4); snv[ai][m] = *(const f32x4*)(J.cs + (size_t)row * 32 + 16 + g4); }
#pragma unroll
                for (int ai = 0; ai < 2; ++ai)
#pragma unroll
                    for (int m = 0; m < 4; ++m) { const int row = u.pm * BM + rloc0 + ai * HALF + m * 16; f32x4 v0 = acc[ai][bj][m][0], v1 = acc[ai][bj][m][1];
                        if (rp) { const f32x4 cs = csv[ai][m], sn = snv[ai][m];
                            const f32x4 o1 = v0 * cs - v1 * sn, o2 = v0 * sn + v1 * cs; v0 = o1; v1 = o2; }
                        v0 *= MLA_QSCALE; v1 *= MLA_QSCALE;
                        u32x4 w; w.x = cvtpk(v0[0], v0[1]); w.y = cvtpk(v0[2], v0[3]); w.z = cvtpk(v1[0], v1[1]); w.w = cvtpk(v1[2], v1[3]);
                        *(u32x4*)(J.O + (size_t)row * 576 + col) = w; } } }
    } else if constexpr (EPI == EPI_KNOPE) {
#pragma unroll
        for (int bj = 0; bj < 2; ++bj) { const int col = u.pn * BM + bj * HALF + cloc0;
            if (col < 384) { const int oc = (col >> 6) * 96 + (col & 63);
#pragma unroll
                for (int ai = 0; ai < 2; ++ai)
#pragma unroll
                    for (int m = 0; m < 4; ++m) { const int row = u.pm * BM + rloc0 + ai * HALF + m * 16; const f32x4 v0 = acc[ai][bj][m][0], v1 = acc[ai][bj][m][1];
                        u32x4 w; w.x = cvtpk(v0[0], v0[1]); w.y = cvtpk(v0[2], v0[3]); w.z = cvtpk(v1[0], v1[1]); w.w = cvtpk(v1[2], v1[3]);
                        *(u32x4*)(J.O + (size_t)row * 576 + oc) = w; } } }
    } else if constexpr (EPI == EPI_SWIGLU) {
#pragma unroll
        for (int ai = 0; ai < 2; ++ai)
#pragma unroll
            for (int m = 0; m < 4; ++m) { const int row = u.pm * BM + rloc0 + ai * HALF + m * 16; u32x4 w; float o[8];
#pragma unroll
                for (int n = 0; n < 2; ++n)
#pragma unroll
                    for (int q = 0; q < 4; q += 2) {
                        const f32x2 g2 = {acc[ai][0][m][n][q], acc[ai][0][m][n][q + 1]}, u2 = {acc[ai][1][m][n][q], acc[ai][1][m][n][q + 1]};
                        f32x2 d2 = {__builtin_amdgcn_exp2f(g2.x), __builtin_amdgcn_exp2f(g2.y)}; d2 += (f32x2){1.f, 1.f};
                        const f32x2 r2 = {__builtin_amdgcn_rcpf(d2.x), __builtin_amdgcn_rcpf(d2.y)}, o2 = (g2 * u2) * r2; o[n * 4 + q] = o2.x; o[n * 4 + q + 1] = o2.y; }
                w.x = cvtpk(o[0], o[1]); w.y = cvtpk(o[2], o[3]); w.z = cvtpk(o[4], o[5]); w.w = cvtpk(o[6], o[7]);
                *(u32x4*)(J.O + (size_t)row * J.ldc + u.pn * HALF + cloc0) = w; }
    } else if constexpr (EPI == EPI_SWIGLU8) {
#pragma unroll
        for (int ai = 0; ai < 2; ++ai)
#pragma unroll
            for (int m = 0; m < 4; ++m) { const int row = u.pm * BM + rloc0 + ai * HALF + m * 16; float o[8];
#pragma unroll
                for (int n = 0; n < 2; ++n)
#pragma unroll
                    for (int q = 0; q < 4; q += 2) {
                        const f32x2 g2 = {acc[ai][0][m][n][q], acc[ai][0][m][n][q + 1]}, u2 = {acc[ai][1][m][n][q], acc[ai][1][m][n][q + 1]};
                        f32x2 d2 = {__builtin_amdgcn_exp2f(g2.x), __builtin_amdgcn_exp2f(g2.y)}; d2 += (f32x2){1.f, 1.f};
                        const f32x2 r2 = {__builtin_amdgcn_rcpf(d2.x), __builtin_amdgcn_rcpf(d2.y)}, o2 = (g2 * u2) * r2; o[n * 4 + q] = o2.x; o[n * 4 + q + 1] = o2.y; }
                u32x2 w; w.x = pk4_fp8(o[0], o[1], o[2], o[3]); w.y = pk4_fp8(o[4], o[5], o[6], o[7]);
                *(u32x2*)((unsigned char*)J.O + (size_t)row * J.ldc + u.pn * HALF + cloc0) = w; }
    } else {
        int slots[2][4];
#pragma unroll
        for (int ai = 0; ai < 2; ++ai)
#pragma unroll
            for (int m = 0; m < 4; ++m) { const int rl = rloc0 + ai * HALF + m * 16; slots[ai][m] = J.glist[u.lidx + (rl < u.nvalid ? rl : u.nvalid - 1)]; }
#pragma unroll
        for (int ai = 0; ai < 2; ++ai)
#pragma unroll
            for (int m = 0; m < 4; ++m) { const int rl = rloc0 + ai * HALF + m * 16;
                bf16* rowp = (rl < u.nvalid) ? J.O + (size_t)slots[ai][m] * J.ldc + u.pn * BM + cloc0 : (bf16*)J.cs + cloc0;
#pragma unroll
                for (int bj = 0; bj < 2; ++bj) { const f32x4 v0 = acc[ai][bj][m][0], v1 = acc[ai][bj][m][1]; u32x4 w; w.x = cvtpk(v0[0], v0[1]); w.y = cvtpk(v0[2], v0[3]); w.z = cvtpk(v1[0], v1[1]); w.w = cvtpk(v1[2], v1[3]);
                    *(u32x4*)(rowp + bj * HALF) = w; } }
    }
}

template <int EPI, bool MOE, bool FP8 = false> DI void gemm_phase(LAS unsigned char* lds, const LAS int* mm, const Job& J, int G, int cu, int wave_id) {
    constexpr bool GATHER = MOE && (EPI == EPI_SWIGLU || EPI == EPI_SWIGLU8);
    constexpr int ESZ = FP8 ? 1 : 2;
    int tid; asm volatile("v_mbcnt_lo_u32_b32 %0, -1, 0\n\tv_mbcnt_hi_u32_b32 %0, -1, %0" : "=v"(tid)); tid += wave_id * 64;
    const int wid = __builtin_amdgcn_readfirstlane(tid >> 6), lane = tid & 63, wr = wid >> 2, wc = wid & 3, fr = lane & 15, fq = lane >> 4;
    const int K = J.K, nt = K * ESZ / 128;
    unsigned voffB[2];
#pragma unroll
    for (int i = 0; i < 2; ++i) { int R, C; stage_rc(tid * 16 + i * 8192, R, C); const int Rb = (R & ~31) + perm32(R & 31); voffB[i] = (unsigned)(Rb * J.ldb * ESZ + C * 2); }
    const size_t kstep = (size_t)(BK * 2);
    const size_t hstepB = (size_t)HALF * J.ldb * ESZ;
    const unsigned ldsw = (unsigned)wid * 1024u;
    const int aoff = lds_byte(wr * 64 + fr, fq * (FP8 ? 16 : 8)), boff = lds_byte(wc * 32 + fr, fq * (FP8 ? 16 : 8));
    constexpr int KOFF = FP8 ? 16 : 1024;
#define PG8_SA(b, h) (((b) * 2 + (h)) * HTB)
#define PG8_SB(b, h) ((4 + (b) * 2 + (h)) * HTB)
#define PG8_STAGE_B(bufoff, gbase) do { _Pragma("unroll") for (int _i = 0; _i < 2; ++_i) \
        __builtin_amdgcn_global_load_lds((const unsigned*)((const char*)(gbase) + voffB[_i]), (LAS unsigned*)(lds + (bufoff) + ldsw + _i * 8192), 16, 0, 0); } while (0)
#define PG8_STAGE_A(bufoff, kbyte, O0, O1) do { \
        __builtin_amdgcn_global_load_lds((const unsigned*)((const char*)J.A + (kbyte) + (O0)), (LAS unsigned*)(lds + (bufoff) + ldsw), 16, 0, 0); \
        __builtin_amdgcn_global_load_lds((const unsigned*)((const char*)J.A + (kbyte) + (O1)), (LAS unsigned*)(lds + (bufoff) + ldsw + 8192), 16, 0, 0); } while (0)
#define PG8_LD8(dst, addr) do { const u32x4 lo_ = *(const LAS u32x4*)(addr), hi_ = *(const LAS u32x4*)((addr) + KOFF); \
        dst = (i32x8){(int)lo_.x, (int)lo_.y, (int)lo_.z, (int)lo_.w, (int)hi_.x, (int)hi_.y, (int)hi_.z, (int)hi_.w}; } while (0)
#define PG8_LDA(dst, b, h) do { _Pragma("unroll") for (int m = 0; m < 4; ++m) PG8_LD8(dst[m], lds + PG8_SA(b, h) + aoff + m * 2048); } while (0)
#define PG8_LDB(dst, b, h) do { _Pragma("unroll") for (int n = 0; n < 2; ++n) PG8_LD8(dst[n], lds + PG8_SB(b, h) + boff + n * 2048); } while (0)
#define PG8_LO(v) __builtin_bit_cast(bf16x8, __builtin_shufflevector(v, v, 0, 1, 2, 3))
#define PG8_HI(v) __builtin_bit_cast(bf16x8, __builtin_shufflevector(v, v, 4, 5, 6, 7))
#define PG8_MMA(ai, bj, At, Bt) do { __builtin_amdgcn_s_setprio(1); _Pragma("unroll") for (int m = 0; m < 4; ++m) _Pragma("unroll") for (int n = 0; n < 2; ++n) { \
        if constexpr (FP8) asm volatile("v_mfma_scale_f32_16x16x128_f8f6f4 %0, %1, %2, %0, %3, %4 op_sel_hi:[0,0,0]" : "+v"(acc[ai][bj][m][n]) : "v"(Bt[n]), "v"(At[m]), "v"(scw), "v"(scw));   \
        else { acc[ai][bj][m][n] = __builtin_amdgcn_mfma_f32_16x16x32_bf16(PG8_LO(Bt[n]), PG8_LO(At[m]), acc[ai][bj][m][n], 0, 0, 0); \
               acc[ai][bj][m][n] = __builtin_amdgcn_mfma_f32_16x16x32_bf16(PG8_HI(Bt[n]), PG8_HI(At[m]), acc[ai][bj][m][n], 0, 0, 0); } } \
        __builtin_amdgcn_s_setprio(0); } while (0)
#define PG8_WAIT_V(n) asm volatile("s_waitcnt vmcnt(" #n ")" ::: "memory")
#define PG8_WAIT_L(n) asm volatile("s_waitcnt lgkmcnt(" #n ")" ::: "memory")
#define PG8_BAR __builtin_amdgcn_s_barrier()
#define PG8_SCHED __builtin_amdgcn_sched_barrier(0)
#define PG8_AOFF(o, U) do { _Pragma("unroll") for (int _h = 0; _h < 2; ++_h) _Pragma("unroll") for (int _i = 0; _i < 2; ++_i) { int _R, _C; stage_rc(tid * 16 + _i * 8192, _R, _C); const int _r = _h * HALF + _R; int _row; \
        if constexpr (GATHER) { _row = J.glist[(U).lidx + (_r < (U).nvalid ? _r : (U).nvalid - 1)] >> 1; } else _row = (U).arow + _r; \
        o[_h * 2 + _i] = (unsigned)(_row * J.lda * ESZ + _C * 2); } } while (0)
    Unit cur, nxt; int ui = 0;
    if (!sched_next<MOE>(J, mm, 0, G, cu, cur)) return;
    f32x4 acc[2][2][4][2];
#pragma unroll
    for (int a = 0; a < 2; ++a)
#pragma unroll
        for (int b = 0; b < 2; ++b)
#pragma unroll
            for (int m = 0; m < 4; ++m)
#pragma unroll
                for (int n = 0; n < 2; ++n) acc[a][b][m][n] = (f32x4){0.f, 0.f, 0.f, 0.f};
    i32x8 At[4], B0[2], B1[2];
    const int scw = 0x7c7c7c7c;
    unsigned oA[4];
    PG8_AOFF(oA, cur);
    const char* cB = (const char*)J.Bt + (size_t)cur.brow * J.ldb * ESZ;
    PG8_STAGE_B(PG8_SB(0, 0), cB); PG8_STAGE_B(PG8_SB(0, 1), cB + hstepB); PG8_STAGE_A(PG8_SA(0, 0), 0, oA[0], oA[1]); PG8_STAGE_A(PG8_SA(0, 1), 0, oA[2], oA[3]);
    if (wr == 1) PG8_BAR;
    PG8_WAIT_V(2); PG8_BAR;
    PG8_STAGE_B(PG8_SB(1, 0), cB + kstep); PG8_STAGE_A(PG8_SA(1, 0), kstep, oA[0], oA[1]); PG8_STAGE_B(PG8_SB(1, 1), cB + hstepB + kstep);
    PG8_WAIT_V(6); PG8_BAR;
    for (;;) {
        bool has_next = false; const char* nB = cB; int graw[4];
        for (int t = 0; t < nt; t += 2) {
            const bool last = (t == nt - 2);
            if constexpr (GATHER) { if (t == nt - 4) {
                has_next = sched_next<MOE>(J, mm, ui + 1, G, cu, nxt);
                if (has_next) {
#pragma unroll
                    for (int h_ = 0; h_ < 2; ++h_)
#pragma unroll
                        for (int i_ = 0; i_ < 2; ++i_) { int R_, C_; stage_rc(tid * 16 + i_ * 8192, R_, C_); const int r_ = h_ * HALF + R_; const int* gp_ = J.glist + nxt.lidx + (r_ < nxt.nvalid ? r_ : nxt.nvalid - 1);
                            asm volatile("global_load_dword %0, %1, off" : "=v"(graw[h_ * 2 + i_]) : "v"(gp_) : "memory"); } } } }
            const size_t k1 = (size_t)(t + 1) * kstep;
            PG8_LDB(B0, 0, 0); PG8_LDB(B1, 0, 1); PG8_SCHED; PG8_LDA(At, 0, 0); PG8_STAGE_A(PG8_SA(1, 1), k1, oA[2], oA[3]);
            PG8_WAIT_V(8); PG8_WAIT_L(0); PG8_BAR; PG8_MMA(0, 0, At, B0); PG8_MMA(0, 1, At, B1); PG8_BAR; PG8_SCHED;
            if (last) {
                if constexpr (GATHER) { if (has_next) {
#pragma unroll
                        for (int q_ = 0; q_ < 4; ++q_) { int R_, C_; stage_rc(tid * 16 + (q_ & 1) * 8192, R_, C_); asm volatile("" : "+v"(graw[q_])); oA[q_] = (unsigned)((graw[q_] >> 1) * J.lda * ESZ + C_ * 2); }
                        nB = (const char*)J.Bt + (size_t)nxt.brow * J.ldb * ESZ; } }
                else { has_next = sched_next<MOE>(J, mm, ui + 1, G, cu, nxt); if (has_next) { PG8_AOFF(oA, nxt); nB = (const char*)J.Bt + (size_t)nxt.brow * J.ldb * ESZ; } } }
            const size_t k2 = last ? 0 : (size_t)(t + 2) * kstep, k3 = k2 + kstep;
            const char* b2 = last ? nB : cB + (size_t)(t + 2) * kstep; const char* b3 = b2 + kstep;
            PG8_LDA(At, 0, 1); PG8_STAGE_B(PG8_SB(0, 0), b2); PG8_STAGE_B(PG8_SB(0, 1), b2 + hstepB); PG8_STAGE_A(PG8_SA(0, 0), k2, oA[0], oA[1]);
            PG8_WAIT_V(8); PG8_WAIT_L(0); PG8_BAR; PG8_MMA(1, 0, At, B0); PG8_MMA(1, 1, At, B1); PG8_BAR; PG8_SCHED;
            PG8_LDB(B0, 1, 0); PG8_LDB(B1, 1, 1); PG8_SCHED; PG8_LDA(At, 1, 0); PG8_STAGE_A(PG8_SA(0, 1), k2, oA[2], oA[3]);
            PG8_WAIT_V(8); PG8_WAIT_L(0); PG8_BAR; PG8_MMA(0, 0, At, B0); PG8_MMA(0, 1, At, B1); PG8_BAR; PG8_SCHED;
            PG8_LDA(At, 1, 1); PG8_STAGE_B(PG8_SB(1, 0), b3); PG8_STAGE_B(PG8_SB(1, 1), b3 + hstepB); PG8_STAGE_A(PG8_SA(1, 0), k3, oA[0], oA[1]);
            PG8_WAIT_V(8); PG8_WAIT_L(0); PG8_BAR; PG8_MMA(1, 0, At, B0); PG8_MMA(1, 1, At, B1); PG8_BAR; PG8_SCHED;
        }
        if (wr == 0) PG8_BAR;
        if constexpr (FP8) {
            asm volatile("s_nop 15\n\ts_nop 15" : "+v"(acc[1][0][0][0]), "+v"(acc[1][0][0][1]), "+v"(acc[1][0][1][0]), "+v"(acc[1][0][1][1]), "+v"(acc[1][0][2][0]), "+v"(acc[1][0][2][1]), "+v"(acc[1][0][3][0]), "+v"(acc[1][0][3][1]),
                                              "+v"(acc[1][1][0][0]), "+v"(acc[1][1][0][1]), "+v"(acc[1][1][1][0]), "+v"(acc[1][1][1][1]), "+v"(acc[1][1][2][0]), "+v"(acc[1][1][2][1]), "+v"(acc[1][1][3][0]), "+v"(acc[1][1][3][1]) :: "memory"); }
        epilogue<EPI>(J, acc, cur, wr, wc, fr, fq);
        if (!has_next) break;
#pragma unroll
        for (int a = 0; a < 2; ++a)
#pragma unroll
            for (int b = 0; b < 2; ++b)
#pragma unroll
                for (int m = 0; m < 4; ++m)
#pragma unroll
                    for (int n = 0; n < 2; ++n) { f32x2 z0, z1; asm volatile("v_pk_mov_b32 %0, 0, 0\n\tv_pk_mov_b32 %1, 0, 0" : "=v"(z0), "=v"(z1)); acc[a][b][m][n] = (f32x4){z0.x, z0.y, z1.x, z1.y}; }
        cur = nxt; cB = nB; ++ui;
        if (wr == 1) PG8_BAR;
    }
    PG8_WAIT_V(0);
    PG8_BAR;
#undef PG8_SA
#undef PG8_SB
#undef PG8_STAGE_A
#undef PG8_STAGE_B
#undef PG8_LDA
#undef PG8_LD8
#undef PG8_LO
#undef PG8_HI
#undef PG8_LDB
#undef PG8_MMA
#undef PG8_WAIT_V
#undef PG8_WAIT_L
#undef PG8_BAR
#undef PG8_SCHED
#undef PG8_AOFF
}
}

struct Args { const void* in[30]; float* out; unsigned char* ws; int ph_lo, ph_hi; };
typedef const __attribute__((address_space(4))) Args* KArgs;
#define IN(i) ((const float*)a->in[i])
struct Frame {
    LAS unsigned char* lds; volatile LAS unsigned* MISC; gu32* ctl;
    int tid, lane, wave, G, cu;
    unsigned char* ws; float* out;
};
#define RELANE(F) do { int l_; asm volatile("v_mbcnt_lo_u32_b32 %0, -1, 0\n\tv_mbcnt_hi_u32_b32 %0, -1, %0" : "=v"(l_)); F.lane = l_; F.tid = F.wave * 64 + l_; } while (0)
enum { I_X = 0, I_C, I_POS, I_WADA, I_BADA, I_GNORM, I_WIN, I_WOUT, I_LQ1, I_LK1, I_LQ2, I_LK2, I_GDIFF, I_WCONV, I_BCONV, I_BIG, I_BFG, I_GML, I_GQL, I_GKVL, I_WUQ, I_WUKV,
       I_WGD, I_WUD, I_WDD, I_WR, I_BR, I_WGE, I_WUE, I_WDE };
__constant__ float ROPE_FREQ[16] = {1.0f, 0.5623413251903491f, 0.31622776601683794f, 0.1778279410038923f, 0.1f, 0.05623413251903491f, 0.031622776601683794f, 0.01778279410038923f,
                                    0.01f, 0.005623413251903491f, 0.0031622776601683794f, 0.001778279410038923f, 0.001f, 0.0005623413251903491f, 0.00031622776601683794f, 0.0001778279410038923f};

struct TrItem { const float* W; int N, k0, n0; int kind; bf16* dst; int ldd; const float* kscale; float wmul; };
DI void tr_load(const TrItem& t, int lane, f32x4 (&v)[8]) {
    const int kr = lane >> 3, nc0 = (lane & 7) * 4, nc = (t.n0 + nc0 + 4 <= t.N) ? nc0 : 0;
#pragma unroll
    for (int i = 0; i < 8; ++i) v[i] = __builtin_nontemporal_load((const GAS f32x4*)(t.W + (size_t)(t.k0 + 8 * i + kr) * t.N + t.n0 + nc));
}
DI int rope_perm(int i) { return (i < 16) ? ((i >> 2) * 8 + (i & 3)) : (((i - 16) >> 2) * 8 + 4 + ((i - 16) & 3)); }
struct MapIdent { DI int operator()(int n) const { return n; } };
struct MapWinP { DI int operator()(int n) const {
    if (n < 512) return n;
    if (n < 768) return -1;
    if (n < 1152) return 1024 + (n - 768);
    if (n < 1536) return 1024 + 384 + (n - 1152);
    if (n < 1920) return -1;
    if (n < 2304) return 512 + (n - 1920);
    if (n < 2316) return 1024 + 768 + (n - 2304);
    if (n < 2508) return 1024 + 784 + (n - 2316);
    if (n < 2636) return 896 + (n - 2508);
    return 1024 + 976 + rope_perm(n - 2636); } };
struct MapWinV { DI int operator()(int n) const { if (n >= 512 && n < 768) return n - 512; if (n >= 1536 && n < 1920) return 256 + (n - 1536); return -1; } };
struct MapUq { DI int operator()(int n) const { const int h = n / 96, d = n % 96; return h * 96 + (d < 64 ? d : 64 + rope_perm(d - 64)); } };
struct MapUkvK { DI int operator()(int n) const { const int h = n >> 7, d = n & 127; return d < 64 ? h * 64 + d : -1; } };
struct MapUkvV { DI int operator()(int n) const { const int h = n >> 7, d = n & 127; return d >= 64 ? h * 64 + d - 64 : -1; } };
struct MapGate { DI int operator()(int n) const { return (n >> 7) * 256 + (n & 127); } };
struct MapUp { DI int operator()(int n) const { return (n >> 7) * 256 + 128 + (n & 127); } };

enum { TK_WINP = 0, TK_WINV, TK_IDENT, TK_UQ, TK_UKVK, TK_UKVV, TK_GATE, TK_UP, TK_GATE8, TK_UP8, TK_IDENT8 };
DI int tr_map(int kind, int n) {
    switch (kind) { case TK_WINP: return MapWinP()(n); case TK_WINV: return MapWinV()(n); case TK_UQ: return MapUq()(n); case TK_UKVK: return MapUkvK()(n); case TK_UKVV: return MapUkvV()(n);
        case TK_GATE: case TK_GATE8: return MapGate()(n); case TK_UP: case TK_UP8: return MapUp()(n); default: return n; }
}
DI void tr_store(const TrItem& t, int lane, const f32x4 (&v)[8], LAS float* scr) {
    const int kr = lane >> 3, nc = (lane & 7) * 4;
#pragma unroll
    for (int i = 0; i < 8; ++i) { const int kk = 8 * i + kr;
#pragma unroll
        for (int q = 0; q < 4; ++q) scr[kk * 33 + nc + q] = v[i][q] * t.wmul; }
    LDS_WAIT(); asm volatile("" ::: "memory");
    const int c = lane & 7; const bool f8 = t.kind >= TK_GATE8;
#pragma unroll
    for (int j = 0; j < 4; ++j) { const int nl = (lane >> 3) + 8 * j, n = t.n0 + nl; const LAS float* s = scr + (8 * c) * 33 + nl;
        if (n < t.N) { const int drow = tr_map(t.kind, n);
            if (drow >= 0) {
                if (f8) { u32x2 o; o.x = pk4_fp8(s[0 * 33] * 64.f, s[1 * 33] * 64.f, s[2 * 33] * 64.f, s[3 * 33] * 64.f); o.y = pk4_fp8(s[4 * 33] * 64.f, s[5 * 33] * 64.f, s[6 * 33] * 64.f, s[7 * 33] * 64.f);
                    *(GAS u32x2*)((unsigned char*)t.dst + (size_t)drow * t.ldd + t.k0 + 8 * c) = o; }
                else { u32x4 o; o.x = cvtpk(s[0 * 33], s[1 * 33]); o.y = cvtpk(s[2 * 33], s[3 * 33]); o.z = cvtpk(s[4 * 33], s[5 * 33]); o.w = cvtpk(s[6 * 33], s[7 * 33]);
                    *(GAS u32x4*)(t.dst + (size_t)drow * t.ldd + t.k0 + 8 * c) = o; } } } }
    LDS_WAIT(); asm volatile("" ::: "memory");
}
DI void tr_decode(Frame& F, KArgs a, int it, TrItem& t) {
    unsigned char* ws = F.ws;
    constexpr int IT_WIN = 16 * 84, IT_WOUT = 16 * 32, IT_UQ = 3 * 18, IT_UKV = 2 * 24, IT_GU = 16 * 112, IT_DN = 56 * 32;
    constexpr int PER_LAYER = 2 * IT_WIN + IT_WOUT + IT_UQ + 2 * IT_UKV;
    constexpr int N_SMALL = DEPTH * PER_LAYER, N_DENSE = 2 * IT_GU + IT_DN;
    int r = it; t.kscale = nullptr; t.wmul = 1.f;
    auto set = [&](const float* W, int N, int nbn, int kind, bf16* dst, int ldd) { t.W = W; t.N = N; t.k0 = 64 * (r / nbn); t.n0 = 32 * (r % nbn); t.kind = kind; t.dst = dst; t.ldd = ldd; };
    if (r < N_SMALL) { const int l = r / PER_LAYER; r -= l * PER_LAYER;
        const float* win = IN(I_WIN) + (size_t)l * D * INW;
        if (r < IT_WIN) { set(win, INW, 84, TK_WINP, (bf16*)(ws + WS_WIN) + (size_t)l * 2048 * 1024, 1024); return; } r -= IT_WIN;
        if (r < IT_WIN) { set(win, INW, 84, TK_WINV, (bf16*)(ws + WS_WV) + (size_t)l * 768 * 1024, 1024); return; } r -= IT_WIN;
        if (r < IT_WOUT) { set(IN(I_WOUT) + (size_t)l * D * D, D, 32, TK_IDENT, (bf16*)(ws + WS_WOUT) + (size_t)l * D * D, D); return; } r -= IT_WOUT;
        if (r < IT_UQ) { set(IN(I_WUQ) + (size_t)l * 192 * 576, 576, 18, TK_UQ, (bf16*)(ws + WS_WUQ) + (size_t)l * 768 * 256, 256); return; } r -= IT_UQ;
        if (r < IT_UKV) { set(IN(I_WUKV) + (size_t)l * 128 * 768, 768, 24, TK_UKVK, (bf16*)(ws + WS_WUKK) + (size_t)l * 512 * 128, 128); return; } r -= IT_UKV;
        set(IN(I_WUKV) + (size_t)l * 128 * 768, 768, 24, TK_UKVV, (bf16*)(ws + WS_WUKV) + (size_t)l * 512 * 128, 128); return; }
    r -= N_SMALL;
    const float *wg, *wu, *wd; bf16 *gu, *dn; bool f8 = DENSE_FP8 != 0, f8d = DENSE_FP8 == 1;
    if (r < N_DENSE) { wg = IN(I_WGD); wu = IN(I_WUD); wd = IN(I_WDD); gu = (bf16*)(ws + WS_WGUD); dn = (bf16*)(ws + WS_WDD); }
    else { r -= N_DENSE; const int e = r / (2 * IT_GU + IT_DN); r -= e * (2 * IT_GU + IT_DN); f8 = true;
        wg = IN(I_WGE) + (size_t)e * D * DFF; wu = IN(I_WUE) + (size_t)e * D * DFF; wd = IN(I_WDE) + (size_t)e * DFF * D; f8d = true;
        gu = (bf16*)(ws + WS_WGUE + (size_t)e * 7168 * 1024); dn = (bf16*)(ws + WS_WDE + (size_t)e * 1024 * 3584); }
    if (r < IT_GU) { set(wg, DFF, 112, f8 ? TK_GATE8 : TK_GATE, gu, 1024); t.wmul = -1.4426950408889634f; return; } r -= IT_GU;
    if (r < IT_GU) { set(wu, DFF, 112, f8 ? TK_UP8 : TK_UP, gu, 1024); t.wmul = -0.6931471805599453f; return; } r -= IT_GU;
    set(wd, D, 32, f8d ? TK_IDENT8 : TK_IDENT, dn, 3584);
}
constexpr int TR_N_SMALL = DEPTH * (2 * 16 * 84 + 16 * 32 + 3 * 18 + 2 * 2 * 24);
constexpr int TR_N_EARLY = TR_N_SMALL + (2 * 16 * 112 + 56 * 32);
constexpr int TR_N_MOE = NEXP * (2 * 16 * 112 + 56 * 32), TR_MOE_CHUNK = 84, TR_MOE_CHUNKS = TR_N_MOE / TR_MOE_CHUNK;
static_assert(TR_MOE_CHUNKS * TR_MOE_CHUNK == TR_N_MOE && TR_MOE_CHUNKS * 4 == 2048, "expert weight items split evenly; one chunk per four mixer units");
DI void tr_run(Frame& F, KArgs a, int first, int end, int stride, LAS float* scr) {
    TrItem tA, tB, tC; f32x4 vA[8], vB[8], vC[8];
    int lane = F.lane; asm volatile("" : "+v"(lane));
    if (first >= end) return;
    const int lastit = first + ((end - 1 - first) / stride) * stride;
    int it = first;
#define TR_CL(x) ((x) <= lastit ? (x) : lastit)
    tr_decode(F, a, it, tA); tr_load(tA, lane, vA);
    tr_decode(F, a, TR_CL(it + stride), tB); tr_load(tB, lane, vB);
    for (;;) {
        tr_decode(F, a, TR_CL(it + 2 * stride), tC); tr_load(tC, lane, vC);
        tr_store(tA, lane, vA, scr); it += stride; if (it > lastit) break;
        tr_decode(F, a, TR_CL(it + 2 * stride), tA); tr_load(tA, lane, vA);
        tr_store(tB, lane, vB, scr); it += stride; if (it > lastit) break;
        tr_decode(F, a, TR_CL(it + 2 * stride), tB); tr_load(tB, lane, vB);
        tr_store(tC, lane, vC, scr); it += stride; if (it > lastit) break;
    }
#undef TR_CL
}
DI void p0_prologue(Frame& F, KArgs a) {
    LAS float* scr = (LAS float*)(F.lds + F.wave * 16384);
    const int gw = F.cu * NWAVES + F.wave, NGW = F.G * NWAVES;
    unsigned char* ws = F.ws;
    tr_run(F, a, gw, (F.G == 256) ? TR_N_SMALL : TR_N_EARLY, NGW, scr);
    { unsigned z = 0u; asm volatile("" : "+v"(z));
      for (int i = gw * 64 + F.lane; i < DEPTH * 768 * 8; i += NGW * 64) { const int row = i >> 3, c = i & 7; *(GAS u32x4*)((bf16*)(ws + WS_WUQ) + (size_t)row * 256 + 192 + c * 8) = (u32x4){z, z, z, z}; } }
    { const int* pos = (const int*)IN(I_POS); float* cs = (float*)(ws + WS_CS);
      for (int i = gw * 64 + F.lane; i < NTOK * 16; i += NGW * 64) { const int row = i >> 4, k = i & 15; const float ang = (float)pos[row] * ROPE_FREQ[k];
          double t = (double)ang * 0.15915494309189535; t -= __builtin_floor(t); const float tf = (float)t;
          cs[(size_t)row * 32 + k] = __builtin_amdgcn_cosf(tf); cs[(size_t)row * 32 + 16 + k] = __builtin_amdgcn_sinf(tf); } }
    __syncthreads();
    { LAS float* sc = (LAS float*)F.lds;
      LAS float* red = (LAS float*)(F.lds + 65536);
      const float* c = IN(I_C);
      for (int i = F.tid; i < 16 * 1024; i += NTHR) sc[(i & 1023) * 16 + (i >> 10)] = siluf(c[i]);
      __syncthreads();
      float* mod = (float*)(ws + WS_MOD);
      for (int item = F.cu; item < 4 * 48; item += F.G) { const int lj = item / 48, n0 = (item % 48) * 64;
          const float* w = IN(I_WADA) + (size_t)lj * D * 3072 + n0 + F.lane; float accv[16];
#pragma unroll
          for (int b = 0; b < 16; ++b) accv[b] = 0.f;
          const int kbeg = F.wave * 128;
          for (int k0 = kbeg; k0 < kbeg + 128; k0 += 32) { float wv[32];
#pragma unroll
              for (int i = 0; i < 32; ++i) wv[i] = w[(size_t)(k0 + i) * 3072];
#pragma unroll
              for (int i = 0; i < 32; ++i) { const LAS f32x4* sp = (const LAS f32x4*)(sc + (k0 + i) * 16); const f32x4 s0 = sp[0], s1 = sp[1], s2 = sp[2], s3 = sp[3]; const float x = wv[i];
                  accv[0] += s0.x * x; accv[1] += s0.y * x; accv[2] += s0.z * x; accv[3] += s0.w * x; accv[4] += s1.x * x; accv[5] += s1.y * x; accv[6] += s1.z * x; accv[7] += s1.w * x;
                  accv[8] += s2.x * x; accv[9] += s2.y * x; accv[10] += s2.z * x; accv[11] += s2.w * x; accv[12] += s3.x * x; accv[13] += s3.y * x; accv[14] += s3.z * x; accv[15] += s3.w * x;
                  if ((i & 3) == 3) __builtin_amdgcn_sched_barrier(0); } }
#pragma unroll
          for (int b = 0; b < 16; ++b) red[(F.wave * 16 + b) * 64 + F.lane] = accv[b];
          __syncthreads();
          for (int o = F.tid; o < 16 * 64; o += NTHR) { const int b = o >> 6, n = o & 63; float s = 0.f;
#pragma unroll
              for (int wv = 0; wv < 8; ++wv) s += red[(wv * 16 + b) * 64 + n];
              mod[((size_t)lj * 16 + b) * 3072 + n0 + n] = s + IN(I_BADA)[(size_t)lj * 3072 + n0 + n]; }
          __syncthreads(); } }
}

DI void row_load_f32(const float* p, int lane, f32x4 (&v)[4]) { const GAS f32x4* q = (const GAS f32x4*)p + lane;
#pragma unroll
    for (int j = 0; j < 4; ++j) v[j] = q[64 * j]; }
DI void row_load_bf16(const bf16* p, int lane, f32x4 (&v)[4]) { const GAS u32x2* q = (const GAS u32x2*)p + lane;
#pragma unroll
    for (int j = 0; j < 4; ++j) { const u32x2 w = q[64 * j]; v[j] = (f32x4){bflo(w.x), bfhi(w.x), bflo(w.y), bfhi(w.y)}; } }
DI void raw_load_bf16(const bf16* p, int lane, u32x2 (&w)[4]) { const GAS u32x2* q = (const GAS u32x2*)p + lane;
#pragma unroll
    for (int j = 0; j < 4; ++j) w[j] = q[64 * j]; }
DI void raw_cvt_bf16(const u32x2 (&w)[4], f32x4 (&v)[4]) {
#pragma unroll
    for (int j = 0; j < 4; ++j) v[j] = (f32x4){bflo(w[j].x), bfhi(w[j].x), bflo(w[j].y), bfhi(w[j].y)}; }
DI float row_rstd(const f32x4 (&v)[4], int lane) { float s = 0.f;
#pragma unroll
    for (int j = 0; j < 4; ++j) s += (v[j].x * v[j].x + v[j].y * v[j].y) + (v[j].z * v[j].z + v[j].w * v[j].w);
    return rsqrtf(wave_sum(s, lane) * (1.f / D) + EPS); }
DI void vec_load(const float* p, int lane, f32x4 (&v)[4]) {
#pragma unroll
    for (int j = 0; j < 4; ++j) v[j] = ((const GAS f32x4*)p)[lane + 64 * j]; }
DI void mod_norm_store(const f32x4 (&x)[4], const f32x4 (&gg)[4], const f32x4 (&sh)[4], const f32x4 (&scv)[4], bf16* orow, int lane, f32x4 (&h)[4], unsigned char* o8row = nullptr) {
    const float rstd = row_rstd(x, lane);
    GAS u32x2* o8 = (GAS u32x2*)orow + lane;
#pragma unroll
    for (int j = 0; j < 4; ++j) {
        h[j] = (x[j] * rstd * gg[j]) * (scv[j] + 1.0f) + sh[j];
        if (orow) { u32x2 w; w.x = cvtpk(h[j].x, h[j].y); w.y = cvtpk(h[j].z, h[j].w); o8[64 * j] = w; }
        if (o8row) ((GAS unsigned*)o8row)[lane + 64 * j] = pk4_fp8(h[j].x, h[j].y, h[j].z, h[j].w); }
}
DI void resid_update(f32x4 (&x)[4], const f32x4 (&y)[4], const f32x4 (&gg)[4], const f32x4 (&gt)[4], int lane) {
    const float rstd = row_rstd(y, lane);
#pragma unroll
    for (int j = 0; j < 4; ++j) x[j] = x[j] + gt[j] * (y[j] * rstd * gg[j]);
}
DI void row_store_bf16(bf16* p, int lane, const f32x4 (&v)[4]) { GAS u32x2* q = (GAS u32x2*)p + lane;
#pragma unroll
    for (int j = 0; j < 4; ++j) { u32x2 w; w.x = cvtpk(v[j].x, v[j].y); w.y = cvtpk(v[j].z, v[j].w); q[64 * j] = w; } }
DI void row_store_f32(float* p, int lane, const f32x4 (&v)[4]) { GAS f32x4* q = (GAS f32x4*)p + lane;
#pragma unroll
    for (int j = 0; j < 4; ++j) q[64 * j] = v[j]; }

DI void phase_row0(Frame& F, KArgs a) {
    const float* mod = (const float*)(F.ws + WS_MOD);
    bf16* hb = (bf16*)(F.ws + WS_HB);
    const int gw = F.cu * NWAVES + F.wave, NGW = F.G * NWAVES;
    (void)gw; (void)NGW;
    for (int blk = F.cu; blk < NTOK / 128; blk += F.G) {
        const int row0 = blk * 128 + F.wave * 16; f32x4 nx[4]; row_load_f32(IN(I_X) + (size_t)row0 * D, F.lane, nx);
        f32x4 vg[4], vsh[4], vsc[4]; { const float* m_ = mod + ((size_t)0 * 16 + (row0 >> 11)) * 3072; vec_load(IN(I_GNORM), F.lane, vg); vec_load(m_, F.lane, vsh); vec_load(m_ + 1024, F.lane, vsc); }
        for (int i = 0; i < 16; ++i) { const int row = row0 + i; f32x4 x[4], h[4];
#pragma unroll
            for (int j = 0; j < 4; ++j) x[j] = nx[j];
            if (i < 15) row_load_f32(IN(I_X) + (size_t)(row + 1) * D, F.lane, nx);
            mod_norm_store(x, vg, vsh, vsc, hb + (size_t)row * D, F.lane, h); } }
}
DI void phase_row1(Frame& F, KArgs a, int l) {
    const float* modA = (const float*)(F.ws + WS_MOD) + (size_t)(l * 2 + 0) * 16 * 3072;
    const float* modB = (const float*)(F.ws + WS_MOD) + (size_t)(l * 2 + 1) * 16 * 3072;
    const float* gn = IN(I_GNORM) + (size_t)l * 4 * D;
    const bf16* y = (const bf16*)(F.ws + WS_Y); bf16* hb = (bf16*)(F.ws + WS_HB);
    bf16* xb = (bf16*)(F.ws + WS_XB);
    const bool moe = (l & 1);
    LAS float* wr_s = (LAS float*)F.lds;
    LAS int* sel = (LAS int*)(F.lds + 32768);
    LAS int* rank = (LAS int*)(F.lds + 32768 + 512);
    LAS int* base = (LAS int*)(F.lds + 32768 + 512 + 1024);
    if (moe) { for (int i = F.tid; i < 8192; i += NTHR) wr_s[i] = IN(I_WR)[i]; __syncthreads(); }
    for (int blk = F.cu; blk < NTOK / 128; blk += F.G) {
        f32x4 vg1[4], vgt[4], vg2[4], vsh[4], vsc[4]; { const int b_ = (blk * 128) >> 11; vec_load(gn + 1 * D, F.lane, vg1); vec_load(modA + (size_t)b_ * 3072 + 2048, F.lane, vgt); vec_load(gn + 2 * D, F.lane, vg2);
            vec_load(modB + (size_t)b_ * 3072, F.lane, vsh); vec_load(modB + (size_t)b_ * 3072 + 1024, F.lane, vsc); }
        f32x4 nx[4]; u32x2 nxb[4], nyb[4];
#define R1_LOAD(row_) do { if (l == 0) row_load_f32(IN(I_X) + (size_t)(row_) * D, F.lane, nx); else raw_load_bf16(xb + (size_t)(row_) * D, F.lane, nxb); raw_load_bf16(y + (size_t)(row_) * D, F.lane, nyb); } while (0)
        R1_LOAD(blk * 128 + F.wave * 16);
        for (int i = 0; i < 16; ++i) { const int rl = F.wave * 16 + i, row = blk * 128 + rl, b = row >> 11;
            f32x4 x[4], yy[4], h[4];
            if (l == 0) {
#pragma unroll
                for (int j = 0; j < 4; ++j) x[j] = nx[j]; } else raw_cvt_bf16(nxb, x);
            raw_cvt_bf16(nyb, yy);
            if (i < 15) R1_LOAD(row + 1);
            resid_update(x, yy, vg1, vgt, F.lane); (void)b;
            row_store_bf16(xb + (size_t)row * D, F.lane, x);
            const bool f8a = moe || DENSE_FP8;
            mod_norm_store(x, vg2, vsh, vsc, f8a ? nullptr : hb + (size_t)row * D, F.lane, h, f8a ? F.ws + WS_H8 + (size_t)row * D : nullptr);
            if (moe) { float lg[8];
#pragma unroll
                for (int e = 0; e < 8; ++e) lg[e] = 0.f;
#pragma unroll
                for (int j = 0; j < 4; ++j)
#pragma unroll
                    for (int q = 0; q < 4; ++q) { const int k = 4 * F.lane + 256 * j + q; const f32x4 w0 = *(const LAS f32x4*)(wr_s + k * 8), w1 = *(const LAS f32x4*)(wr_s + k * 8 + 4); const float hv = h[j][q];
                        lg[0] += hv * w0.x; lg[1] += hv * w0.y; lg[2] += hv * w0.z; lg[3] += hv * w0.w; lg[4] += hv * w1.x; lg[5] += hv * w1.y; lg[6] += hv * w1.z; lg[7] += hv * w1.w; }
#pragma unroll
                for (int e = 0; e < 8; ++e) lg[e] = wave_sum(lg[e], F.lane) + IN(I_BR)[e];
                int e0 = 0; float v0 = lg[0];
#pragma unroll
                for (int e = 1; e < 8; ++e) if (lg[e] > v0) { v0 = lg[e]; e0 = e; }
                int e1 = -1; float v1 = -INFINITY;
#pragma unroll
                for (int e = 0; e < 8; ++e) if (e != e0 && lg[e] > v1) { v1 = lg[e]; e1 = e; }
                const float p1 = __expf(v1 - v0), g0 = 1.f / (1.f + p1), g1 = p1 / (1.f + p1);
                if (F.lane == 0) { sel[rl] = e0 | (e1 << 8); float* gt = (float*)(F.ws + WS_GATE); gt[(size_t)row * 2] = g0; gt[(size_t)row * 2 + 1] = g1; } }
        }
        if (moe) { __syncthreads();
            LAS int* wcnt = rank;
            int my_e = -1, my_r = 0;
            if (F.tid < 256) { const int rl = F.tid >> 1, k = F.tid & 1; const int s = sel[rl]; my_e = k ? (s >> 8) : (s & 255);
                const unsigned long long below = (1ull << F.lane) - 1ull;
#pragma unroll
                for (int e = 0; e < 8; ++e) { const unsigned long long m = __builtin_amdgcn_ballot_w64(my_e == e); if (my_e == e) my_r = __builtin_popcountll(m & below);
                    if (F.lane == 0) wcnt[F.wave * 8 + e] = __builtin_popcountll(m); } }
            __syncthreads();
            if (F.tid < 8) { const int e = F.tid; const int n = wcnt[e] + wcnt[8 + e] + wcnt[16 + e] + wcnt[24 + e];
                base[e] = (int)__hip_atomic_fetch_add((unsigned*)(F.ctl + CW_MOECNT + e), (unsigned)n, __ATOMIC_RELAXED, __HIP_MEMORY_SCOPE_AGENT); }
            __syncthreads();
            if (F.tid < 256) { int off = base[my_e] + my_r;
                for (int w2 = 0; w2 < F.wave; ++w2) off += wcnt[w2 * 8 + my_e];
                int* list = (int*)(F.ws + WS_LIST); list[my_e * 32768 + off] = (blk * 128 + (F.tid >> 1)) * 2 + (F.tid & 1); }
            __syncthreads(); }
    }
#undef R1_LOAD
}
DI void phase_row2(Frame& F, KArgs a, int l) {
    const float* modB = (const float*)(F.ws + WS_MOD) + (size_t)(l * 2 + 1) * 16 * 3072;
    const float* gn = IN(I_GNORM) + (size_t)l * 4 * D;
    bf16* hb = (bf16*)(F.ws + WS_HB);
    const bool moe = (l & 1);
    const int gw = F.cu * NWAVES + F.wave, NGW = F.G * NWAVES;
    (void)gw; (void)NGW;
    for (int blk = F.cu; blk < NTOK / 128; blk += F.G) {
      f32x4 vg3[4], vgt[4], vgn[4], vsh[4], vsc[4]; { const int b_ = (blk * 128) >> 11; vec_load(gn + 3 * D, F.lane, vg3); vec_load(modB + (size_t)b_ * 3072 + 2048, F.lane, vgt);
          if (l + 1 < DEPTH) { const float* modN_ = (const float*)(F.ws + WS_MOD) + (size_t)((l + 1) * 2) * 16 * 3072 + (size_t)b_ * 3072; vec_load(IN(I_GNORM) + (size_t)(l + 1) * 4 * D, F.lane, vgn); vec_load(modN_, F.lane, vsh); vec_load(modN_ + 1024, F.lane, vsc); } }
      u32x2 nxb[4], nya[4], nyb[4]; float ng0 = 0.f, ng1 = 0.f;
#define R2_LOAD(row_) do { raw_load_bf16((const bf16*)(F.ws + WS_XB) + (size_t)(row_) * D, F.lane, nxb); \
        if (!moe) raw_load_bf16((const bf16*)(F.ws + WS_Y2) + (size_t)(row_) * D, F.lane, nya); \
        else { const bf16* ym_ = (const bf16*)(F.ws + WS_YM); const float* gt_ = (const float*)(F.ws + WS_GATE); raw_load_bf16(ym_ + (size_t)((row_) * 2) * D, F.lane, nya); raw_load_bf16(ym_ + (size_t)((row_) * 2 + 1) * D, F.lane, nyb); \
               ng0 = gt_[(size_t)(row_) * 2]; ng1 = gt_[(size_t)(row_) * 2 + 1]; } } while (0)
      R2_LOAD(blk * 128 + F.wave * 16);
      for (int i = 0; i < 16; ++i) { const int row = blk * 128 + F.wave * 16 + i, b = row >> 11; f32x4 x[4], yy[4];
        raw_cvt_bf16(nxb, x);
        if (!moe) raw_cvt_bf16(nya, yy);
        else { f32x4 ya[4], yb[4]; raw_cvt_bf16(nya, ya); raw_cvt_bf16(nyb, yb); const float g0 = ng0, g1 = ng1;
#pragma unroll
            for (int j = 0; j < 4; ++j) yy[j] = ya[j] * g0 + yb[j] * g1; }
        if (i < 15) R2_LOAD(row + 1);
        resid_update(x, yy, vg3, vgt, F.lane); (void)b;
        if (l + 1 < DEPTH) row_store_bf16((bf16*)(F.ws + WS_XB) + (size_t)row * D, F.lane, x); else row_store_f32(F.out + (size_t)row * D, F.lane, x);
        if (l + 1 < DEPTH) { f32x4 h[4]; mod_norm_store(x, vgn, vsh, vsc, hb + (size_t)row * D, F.lane, h); }
      } }
#undef R2_LOAD
}

DI void phase_fix(Frame& F, KArgs a, int l) {
    const bf16* P1 = (const bf16*)(F.ws + WS_P1); const bf16* P2 = (const bf16*)(F.ws + WS_P2);
    const int gw = F.cu * NWAVES + F.wave, NGW = F.G * NWAVES;
    float* bt2 = (float*)(F.ws + WS_BT2); float* a2 = (float*)(F.ws + WS_A2);
    for (int it = F.cu; it < 96; it += F.G) { const int b = it / 6, h = it % 6; const float bi = IN(I_BIG)[l * 6 + h], bfg = IN(I_BFG)[l * 6 + h];
        LAS float* wt = (LAS float*)F.lds;
        const int t0 = F.wave * 256 + F.lane * 4; float lf[4], ig[4]; float tot = 0.f;
#pragma unroll
        for (int i = 0; i < 4; ++i) { const size_t row = (size_t)b * SEQ + t0 + i; const float fg = bf2f(P2[row * 1024 + 774 + h]) + bfg; ig[i] = bf2f(P2[row * 1024 + 768 + h]) + bi;
            const float ls = (fg >= 0.f) ? -__logf(1.f + __expf(-fg)) : fg - __logf(1.f + __expf(fg)); tot += ls; lf[i] = tot; }
        float incl = tot;
#pragma unroll
        for (int o = 1; o < 64; o <<= 1) { const float t = lane_read(incl, F.lane - o); if (F.lane >= o) incl += t; }
        const float excl = incl - tot;
        if (F.lane == 63) wt[F.wave] = incl;
        __syncthreads();
        float base = 0.f;
        for (int w2 = 0; w2 < F.wave; ++w2) base += wt[w2];
        f32x4 Bv, Av;
#pragma unroll
        for (int i = 0; i < 4; ++i) { const float B = (base + excl + lf[i]) * LOG2E; Bv[i] = B; Av[i] = ig[i] * LOG2E - B; }
        const size_t o = (size_t)it * SEQ + t0; *(GAS f32x4*)(bt2 + o) = Bv; *(GAS f32x4*)(a2 + o) = Av;
        __syncthreads();
    }
    bf16* cqn = (bf16*)(F.ws + WS_CQN); bf16* ckvn = (bf16*)(F.ws + WS_CKVN); bf16* kc = (bf16*)(F.ws + WS_KC); bf16* qbc = (bf16*)(F.ws + WS_QBC); bf16* kbc = (bf16*)(F.ws + WS_KBC);
    const float* cs = (const float*)(F.ws + WS_CS);
    const float* wconv = IN(I_WCONV) + (size_t)l * 4 * 768; const float* bconv = IN(I_BCONV) + (size_t)l * 768;
    for (int run = gw; run < NTOK / 16; run += NGW) {
    const int row0 = run * 16; u32x2 pv[3][3]; f32x4 wcv[4][3], bcv[3];
#pragma unroll
    for (int g = 0; g < 3; ++g) { const int ch = (g * 64 + F.lane) * 4; bcv[g] = *(const GAS f32x4*)(bconv + ch);
#pragma unroll
        for (int j = 0; j < 4; ++j) wcv[j][g] = *(const GAS f32x4*)(wconv + j * 768 + ch);
#pragma unroll
        for (int j = 0; j < 3; ++j) { pv[j][g] = (u32x2){0u, 0u}; if ((row0 & (SEQ - 1)) - 3 + j >= 0) pv[j][g] = *(const GAS u32x2*)(P2 + (size_t)(row0 - 3 + j) * 1024 + ch); } }
    f32x4 gq4 = {0.f, 0.f, 0.f, 0.f}; if (F.lane < 48) gq4 = *(const GAS f32x4*)(IN(I_GQL) + l * 192 + 4 * F.lane);
    const f32x2 gk2 = *(const GAS f32x2*)(IN(I_GKVL) + l * 128 + 2 * F.lane);
    const int kg = (F.lane >> 2) & 3, kj = F.lane & 3;
    u32x2 n_cq = {0u, 0u}, n_cur[3]; unsigned n_ckv; unsigned short n_u1, n_u2; float n_c, n_sn;
#define FIX_LOAD(row_) do { const size_t r_ = (size_t)(row_); n_cq = (u32x2){0u, 0u}; if (F.lane < 48) n_cq = *(const GAS u32x2*)(P2 + r_ * 1024 + 784 + 4 * F.lane); \
        n_ckv = *(const GAS unsigned*)(P1 + r_ * 1024 + 896 + 2 * F.lane); \
        n_u1 = *(const GAS unsigned short*)(P2 + r_ * 1024 + 976 + kg * 8 + kj); n_u2 = *(const GAS unsigned short*)(P2 + r_ * 1024 + 976 + kg * 8 + 4 + kj); \
        n_c = cs[r_ * 32 + kg * 4 + kj]; n_sn = cs[r_ * 32 + 16 + kg * 4 + kj]; \
        _Pragma("unroll") for (int g_ = 0; g_ < 3; ++g_) n_cur[g_] = *(const GAS u32x2*)(P2 + r_ * 1024 + (g_ * 64 + F.lane) * 4); } while (0)
    FIX_LOAD(row0);
    for (int ri = 0; ri < 16; ++ri) { const int row = row0 + ri;
        const u32x2 w_cq = n_cq; const unsigned w_ckv = n_ckv; const float u1 = bf2f(n_u1), u2 = bf2f(n_u2), c = n_c, sn = n_sn; u32x2 curv[3];
#pragma unroll
        for (int g = 0; g < 3; ++g) curv[g] = n_cur[g];
        if (ri < 15) FIX_LOAD(row + 1);
        { const float v0 = bflo(w_cq.x), v1 = bfhi(w_cq.x), v2 = bflo(w_cq.y), v3 = bfhi(w_cq.y), k0 = bflo(w_ckv), k1 = bfhi(w_ckv);
          float sq = v0 * v0 + v1 * v1 + v2 * v2 + v3 * v3, sk = k0 * k0 + k1 * k1; wave_sum2(sq, sk, F.lane);
          const float rq = rsqrtf(sq * (1.f / 192.f) + EPS), rk = rsqrtf(sk * (1.f / 128.f) + EPS);
          u32x2 o; o.x = cvtpk(v0 * rq * gq4.x, v1 * rq * gq4.y); o.y = cvtpk(v2 * rq * gq4.z, v3 * rq * gq4.w); *(GAS u32x2*)(cqn + (size_t)row * 256 + 4 * F.lane) = o;
          *(GAS unsigned*)(ckvn + (size_t)row * 128 + 2 * F.lane) = cvtpk(k0 * rk * gk2.x, k1 * rk * gk2.y); }
        { const int g = kg, j = kj; const float o1 = u1 * c - u2 * sn, o2 = u1 * sn + u2 * c;
          if (F.lane < 16) {
#pragma unroll
              for (int h = 0; h < 6; ++h) { kc[(size_t)row * 576 + h * 96 + 64 + g * 8 + j] = (bf16)(cvtpk(o1, 0.f) & 0xffffu); kc[(size_t)row * 576 + h * 96 + 64 + g * 8 + 4 + j] = (bf16)(cvtpk(o2, 0.f) & 0xffffu); } } }
#pragma unroll
        for (int g = 0; g < 3; ++g) { const int ch = (g * 64 + F.lane) * 4; float accv[4];
            const u32x2 cur = curv[g];
#pragma unroll
            for (int q = 0; q < 4; ++q) accv[q] = bcv[g][q];
#pragma unroll
            for (int j = 0; j < 4; ++j) { const u32x2 w = (j < 3) ? pv[j][g] : cur; const f32x4 wc = wcv[j][g];
                accv[0] += bflo(w.x) * wc.x; accv[1] += bfhi(w.x) * wc.y; accv[2] += bflo(w.y) * wc.z; accv[3] += bfhi(w.y) * wc.w; }
            pv[0][g] = pv[1][g]; pv[1][g] = pv[2][g]; pv[2][g] = cur;
            const float sc = (ch >= 384) ? 0.125f : 1.0f;
            u32x2 o; o.x = cvtpk(siluf(accv[0]) * sc, siluf(accv[1]) * sc); o.y = cvtpk(siluf(accv[2]) * sc, siluf(accv[3]) * sc);
            if (ch < 384) *(GAS u32x2*)(qbc + (size_t)row * 384 + ch) = o; else *(GAS u32x2*)(kbc + (size_t)row * 384 + ch - 384) = o; }
#undef FIX_LOAD
    } }
}

#define MFMA32(a, b, c) __builtin_amdgcn_mfma_f32_32x32x16_bf16((a), (b), (c), 0, 0, 0)
template <int DQK> struct AttnLds { static constexpr int KP = DQK + 8; static constexpr int KBYTES = 64 * KP * 2; static constexpr int VP = 68, VBYTES = 64 * VP * 2; };
constexpr int ATT_K_OFF = 0, ATT_V_OFF = 40960, ATT_G_OFF = 61440;

template <int DQK> DI void attn_qk(const LAS unsigned char* Kb, const bf16x8 (&qf)[DQK / 16], f32x16& s0, f32x16& s1, int r32, int hi) {
    typedef AttnLds<DQK> L; constexpr int KS = DQK / 16;
    s0 = f32x16{}; s1 = f32x16{};
    constexpr int BS = (KS > 2) ? 2 : KS;
#pragma unroll
    for (int b0 = 0; b0 < KS; b0 += BS) { bf16x8 k0[BS], k1[BS];
#pragma unroll
        for (int i = 0; i < BS; ++i) { k0[i] = *(const LAS bf16x8*)(Kb + (r32 * L::KP + (b0 + i) * 16 + hi * 8) * 2); k1[i] = *(const LAS bf16x8*)(Kb + ((32 + r32) * L::KP + (b0 + i) * 16 + hi * 8) * 2); }
        __builtin_amdgcn_sched_barrier(0);
#pragma unroll
        for (int i = 0; i < BS; ++i) { s0 = MFMA32(k0[i], qf[b0 + i], s0); s1 = MFMA32(k1[i], qf[b0 + i], s1); }
        __builtin_amdgcn_sched_barrier(0); }
}
template <int DQK, bool MLSTM>
DI void attn_sm_pv(f32x16& s0, f32x16& s1, const LAS unsigned char* Vb, const LAS float* gs, f32x16 (&o)[2], float& lsum, float& mrun, float cscale, float bt2q, bool diag, int tq, int r32, int hi) {
    typedef AttnLds<DQK> L;
    if (!MLSTM) {
        float mx = s0[0];
#pragma unroll
        for (int r = 1; r < 16; ++r) mx = fmaxf(mx, s0[r]);
#pragma unroll
        for (int r = 0; r < 16; ++r) mx = fmaxf(mx, s1[r]);
        mx = half_swap_max(mx);
        if (__builtin_amdgcn_ballot_w64(mx > mrun) != 0ull) {
            const float mnew = fmaxf(mrun, mx), alpha = __builtin_amdgcn_exp2f((mrun - mnew) * cscale); mrun = mnew; lsum *= alpha;
#pragma unroll
            for (int r = 0; r < 16; ++r) { o[0][r] *= alpha; o[1][r] *= alpha; } }
        const float mc = mrun * cscale; float ps = 0.f;
#ifdef ATT_DBL_SM
        { f32x16 t0 = s0, t1 = s1; float mx2 = t0[0];
#pragma unroll
          for (int r = 1; r < 16; ++r) mx2 = fmaxf(mx2, t0[r] * 1.0001f);
#pragma unroll
          for (int r = 0; r < 16; ++r) mx2 = fmaxf(mx2, t1[r] * 1.0001f);
          float ps2 = mx2;
#pragma unroll
          for (int r = 0; r < 16; ++r) { t0[r] = __builtin_amdgcn_exp2f(t0[r] * cscale - mc * 1.0001f); t1[r] = __builtin_amdgcn_exp2f(t1[r] * cscale - mc * 1.0001f); ps2 += t0[r] + t1[r]; }
          unsigned acc2 = 0;
#pragma unroll
          for (int r = 0; r < 16; r += 2) { acc2 ^= cvtpk(t0[r], t0[r + 1]); acc2 ^= cvtpk(t1[r], t1[r + 1]); }
          asm volatile("" :: "v"(ps2), "v"(acc2)); }
#endif
#pragma unroll
        for (int r = 0; r < 16; ++r) { s0[r] = __builtin_amdgcn_exp2f(s0[r] * cscale - mc); s1[r] = __builtin_amdgcn_exp2f(s1[r] * cscale - mc); ps += s0[r] + s1[r]; }
        lsum += ps;
    } else {
        float ps = 0.f;
#pragma unroll
        for (int g = 0; g < 4; ++g) { const f32x4 ga = *(const LAS f32x4*)(gs + 8 * g + 4 * hi), gb = *(const LAS f32x4*)(gs + 32 + 8 * g + 4 * hi);
#pragma unroll
            for (int q = 0; q < 4; ++q) { const int r = 4 * g + q, key = 8 * g + 4 * hi + q;
                float w0 = __builtin_amdgcn_exp2f(bt2q + ga[q]), w1 = __builtin_amdgcn_exp2f(bt2q + gb[q]);
                if (diag) { if (key > tq) w0 = 0.f; if (key + 32 > tq) w1 = 0.f; }
                s0[r] *= w0; s1[r] *= w1; ps += s0[r] + s1[r]; } }
        lsum += ps;
    }
    bf16x8 pf[4];
#pragma unroll
    for (int s = 0; s < 2; ++s) { u32x4 t0, t1;
        t0.x = cvtpk(s0[8 * s + 0], s0[8 * s + 1]); t0.y = cvtpk(s0[8 * s + 2], s0[8 * s + 3]); t0.z = cvtpk(s0[8 * s + 4], s0[8 * s + 5]); t0.w = cvtpk(s0[8 * s + 6], s0[8 * s + 7]);
        t1.x = cvtpk(s1[8 * s + 0], s1[8 * s + 1]); t1.y = cvtpk(s1[8 * s + 2], s1[8 * s + 3]); t1.z = cvtpk(s1[8 * s + 4], s1[8 * s + 5]); t1.w = cvtpk(s1[8 * s + 6], s1[8 * s + 7]);
        pf[s] = __builtin_bit_cast(bf16x8, t0); pf[2 + s] = __builtin_bit_cast(bf16x8, t1); }
    { u32x4 av0[4], av1[4];
#define ATT_VRD(dst, d) do { _Pragma("unroll") for (int kk = 0; kk < 4; ++kk) { const int kbase = 32 * (kk >> 1) + 16 * (kk & 1) + 4 * hi; const LAS unsigned char* vp = Vb + ((32 * (d) + r32) * L::VP + kbase) * 2; \
          const u32x2 lo = *(const LAS u32x2*)vp, hh = *(const LAS u32x2*)(vp + 16); dst[kk] = (u32x4){lo.x, lo.y, hh.x, hh.y}; } } while (0)
      ATT_VRD(av0, 0);
      __builtin_amdgcn_sched_barrier(0);
      ATT_VRD(av1, 1);
#pragma unroll
      for (int kk = 0; kk < 4; ++kk) o[0] = MFMA32(__builtin_bit_cast(bf16x8, av0[kk]), pf[kk], o[0]);
      __builtin_amdgcn_sched_barrier(0);
#pragma unroll
      for (int kk = 0; kk < 4; ++kk) o[1] = MFMA32(__builtin_bit_cast(bf16x8, av1[kk]), pf[kk], o[1]);
      __builtin_amdgcn_sched_barrier(0);
#undef ATT_VRD
    }
}
#define SB_ __builtin_amdgcn_sched_barrier(0)
template <int DQK, bool DOQK = true, bool CI = false>
DI void attn_step_fused(const LAS unsigned char* Kb, const bf16x8 (&qf)[DQK / 16], f32x16& n0, f32x16& n1, f32x16& s0, f32x16& s1, const LAS unsigned char* Vb, f32x16 (&o)[2], float& lsum, float& mrun, float cscale, int r32, int hi, f32x16* negm = nullptr) {
    typedef AttnLds<DQK> L; constexpr int KS = DQK / 16; static_assert(KS == 6 || KS == 4 || KS == 2, "");
    constexpr int FVP = 72;
    bf16x8 ka[2], kb[2]; u32x4 va[2][2]; bf16x8 pf[4];
#define FS_LDK(b0_) do { _Pragma("unroll") for (int i = 0; i < 2; ++i) { ka[i] = *(const LAS bf16x8*)(Kb + (r32 * L::KP + ((b0_) + i) * 16 + hi * 8) * 2); kb[i] = *(const LAS bf16x8*)(Kb + ((32 + r32) * L::KP + ((b0_) + i) * 16 + hi * 8) * 2); } } while (0)
#define FS_LDV(slot, kk) do { _Pragma("unroll") for (int d = 0; d < 2; ++d) va[slot][d] = *(const LAS u32x4*)(Vb + ((32 * d + r32) * FVP + 16 * (kk) + 8 * hi) * 2); } while (0)
#define FS_EXPG(S, r) do { if constexpr (CI) { S[r] = __builtin_amdgcn_exp2f(S[r]); S[(r) + 1] = __builtin_amdgcn_exp2f(S[(r) + 1]); } \
        else { S[r] = __builtin_amdgcn_exp2f(S[r] * cscale - mc); S[(r) + 1] = __builtin_amdgcn_exp2f(S[(r) + 1] * cscale - mc); } ps += S[r] + S[(r) + 1]; } while (0)
#define FS_CVT(dst, S, r) do { u32x4 t_; t_.x = cvtpk(S[(r) + 0], S[(r) + 1]); t_.y = cvtpk(S[(r) + 2], S[(r) + 3]); t_.z = cvtpk(S[(r) + 4], S[(r) + 5]); t_.w = cvtpk(S[(r) + 6], S[(r) + 7]); dst = __builtin_bit_cast(bf16x8, t_); } while (0)
#define FS_PV(kk, d, slot) do { o[d] = MFMA32(__builtin_bit_cast(bf16x8, va[slot][d]), pf[kk], o[d]); } while (0)
    if constexpr (DOQK) { FS_LDK(0); } SB_;
    float mx = s0[0];
#pragma unroll
    for (int r = 1; r < 16; ++r) mx = fmaxf(mx, s0[r]);
#pragma unroll
    for (int r = 0; r < 16; ++r) mx = fmaxf(mx, s1[r]);
    mx = half_swap_max(mx);
    SB_;
    if constexpr (CI) {
        if (__builtin_amdgcn_ballot_w64(mx > 8.f) != 0ull) {
            const float delta = mx > 8.f ? mx : 0.f, alpha = __builtin_amdgcn_exp2f(-delta); lsum *= alpha;
#pragma unroll
            for (int r = 0; r < 16; ++r) { o[0][r] *= alpha; o[1][r] *= alpha; s0[r] -= delta; s1[r] -= delta; (*negm)[r] -= delta; } }
        SB_;
        if constexpr (DOQK) { n0 = MFMA32(ka[0], qf[0], *negm); SB_; n1 = MFMA32(kb[0], qf[0], *negm); SB_; }
    } else {
    if constexpr (DOQK) { n0 = MFMA32(ka[0], qf[0], f32x16{}); SB_;
    n1 = MFMA32(kb[0], qf[0], f32x16{}); SB_; }
    if (__builtin_amdgcn_ballot_w64((mx - mrun) * cscale > 8.f) != 0ull) {
        const float mnew = ((mx - mrun) * cscale > 8.f) ? mx : mrun, alpha = __builtin_amdgcn_exp2f((mrun - mnew) * cscale); mrun = mnew; lsum *= alpha;
#pragma unroll
        for (int r = 0; r < 16; ++r) { o[0][r] *= alpha; o[1][r] *= alpha; } }
    }
    const float mc = mrun * cscale; float ps = 0.f; (void)mc;
    SB_;
    if constexpr (DOQK) { n0 = MFMA32(ka[1], qf[1], n0); SB_; }
    FS_EXPG(s0, 0); SB_;
    if constexpr (DOQK) { n1 = MFMA32(kb[1], qf[1], n1); SB_; }
    if constexpr (DOQK && KS >= 4) { FS_LDK(2); } FS_LDV(0, 0); SB_;
    FS_EXPG(s0, 2); FS_EXPG(s0, 4); FS_EXPG(s0, 6); SB_;
    FS_CVT(pf[0], s0, 0); SB_;
    if constexpr (DOQK && KS >= 4) {
        n0 = MFMA32(ka[0], qf[2], n0); SB_; FS_EXPG(s0, 8); SB_;
        n1 = MFMA32(kb[0], qf[2], n1); SB_; FS_EXPG(s0, 10); SB_;
        n0 = MFMA32(ka[1], qf[3], n0); SB_; FS_EXPG(s0, 12); SB_;
        n1 = MFMA32(kb[1], qf[3], n1); SB_; FS_EXPG(s0, 14); SB_;
    } else { FS_EXPG(s0, 8); FS_EXPG(s0, 10); FS_EXPG(s0, 12); FS_EXPG(s0, 14); SB_; }
    if constexpr (DOQK && KS >= 6) { FS_LDK(4); } FS_LDV(1, 1); SB_;
    FS_CVT(pf[1], s0, 8); SB_;
    FS_PV(0, 0, 0); SB_; FS_EXPG(s1, 0); SB_;
    FS_PV(0, 1, 0); SB_; FS_EXPG(s1, 2); SB_;
    FS_LDV(0, 2); SB_;
    if constexpr (DOQK && KS >= 6) {
        n0 = MFMA32(ka[0], qf[4], n0); SB_; FS_EXPG(s1, 4); SB_;
        n1 = MFMA32(kb[0], qf[4], n1); SB_; FS_EXPG(s1, 6); SB_;
        n0 = MFMA32(ka[1], qf[5], n0); SB_; FS_CVT(pf[2], s1, 0); SB_;
        n1 = MFMA32(kb[1], qf[5], n1); SB_; FS_EXPG(s1, 8); SB_;
    } else { FS_EXPG(s1, 4); FS_EXPG(s1, 6); SB_; FS_CVT(pf[2], s1, 0); SB_; FS_EXPG(s1, 8); SB_; }
    FS_PV(1, 0, 1); SB_; FS_EXPG(s1, 10); SB_;
    FS_PV(1, 1, 1); SB_; FS_EXPG(s1, 12); SB_;
    FS_LDV(1, 3); SB_;
    FS_PV(2, 0, 0); SB_; FS_EXPG(s1, 14); SB_;
    FS_PV(2, 1, 0); SB_; FS_CVT(pf[3], s1, 8); lsum += ps; SB_;
    FS_PV(3, 0, 1); SB_;
    FS_PV(3, 1, 1); SB_;
#undef FS_LDK
#undef FS_LDV
#undef FS_EXPG
#undef FS_CVT
#undef FS_PV
}
template <int DQK, bool MLSTM>
DI void attn_pass(Frame& F, const bf16* Qp, int qpitch, const bf16* Kp, int kpitch, const bf16* Vt, const float* a2g  , float bt2q, int b, int qb, float cscale,
                  f32x16 (&o)[2], float& lsum, int t0 = 0  ) {
    typedef AttnLds<DQK> L;
    constexpr bool CIM = !MLSTM && ATT_FUSED && ATT_CINIT;
    constexpr bool VPM = !MLSTM && ATT_FUSED; constexpr int VPx = VPM ? 72 : L::VP, VBx = 64 * VPx * 2;
    constexpr int KS = DQK / 16, KPIECES = 64 * DQK / 8, KREG = (KPIECES + NTHR - 1) / NTHR;
    const int lane = F.lane, r32 = lane & 31, hi = lane >> 5, w = F.wave;
    const int NT = 4 * qb + 4, myc = 4 * qb + (w >> 1);
    LAS unsigned char* lds = F.lds;
    bf16x8 qf[KS];
    { const bf16* qrow = Qp + (size_t)(b * SEQ + qb * 256 + w * 32 + r32) * qpitch;
#pragma unroll
      for (int ks = 0; ks < KS; ++ks) qf[ks] = *(const GAS bf16x8*)(qrow + ks * 16 + hi * 8); }
    o[0] = f32x16{}; o[1] = f32x16{}; lsum = 0.f; float mrun = -INFINITY; f32x16 negm = f32x16{};
    u32x4 kregA[KREG], vregA, kregB[KREG], vregB; float gregA = 0.f, gregB = 0.f;
    const int vrow = F.tid >> 3, vc = F.tid & 7, tq = (w & 1) * 32 + r32;
    unsigned koff[KREG];
#pragma unroll
    for (int q_ = 0; q_ < KREG; ++q_) { const int p_ = (F.tid + q_ * NTHR < KPIECES) ? F.tid + q_ * NTHR : F.tid, row_ = p_ / (DQK / 8), c_ = p_ % (DQK / 8); koff[q_] = (unsigned)(row_ * kpitch + c_ * 8) * 2u; }
    const unsigned voff = (unsigned)(((F.tid >> 3) * NTOK + (F.tid & 7) * 8) * 2);
    const char* const wsb = (const char*)F.ws;
    const unsigned kb32 = (unsigned)((const char*)Kp - wsb) + (unsigned)b * (unsigned)(SEQ * 2) * (unsigned)kpitch, vb32 = (unsigned)((const char*)Vt - wsb) + (unsigned)b * (unsigned)(SEQ * 2);
#define ATT_LOADK(KR, kt) do { const unsigned kt_ = kb32 + (unsigned)(kt) * (unsigned)(64 * 2) * (unsigned)kpitch; \
        _Pragma("unroll") for (int q_ = 0; q_ < KREG; ++q_) KR[q_] = *(const GAS u32x4*)(wsb + (size_t)(kt_ + koff[q_])); } while (0)
#define ATT_WRITEK(KR, kbuf) do { \
        _Pragma("unroll") for (int q_ = 0; q_ < KREG; ++q_) { const int p_ = F.tid + q_ * NTHR; if (p_ < KPIECES) { const int row_ = p_ / (DQK / 8), c_ = p_ % (DQK / 8); \
            *(LAS u32x4*)(lds + ATT_K_OFF + (kbuf) * 13312 + (row_ * L::KP + c_ * 8) * 2) = KR[q_]; } } } while (0)
#define ATT_LOAD(KR, VR, GR, j) do { ATT_LOADK(KR, ((j) + 1 < NT) ? (j) + 1 : NT - 1); \
        VR = *(const GAS u32x4*)(wsb + (size_t)(vb32 + (unsigned)(j) * 128u + voff)); \
        if constexpr (MLSTM) GR = a2g[(j) * 64 + (F.tid & 63)]; } while (0)
#define ATT_WRITE(KR, VR, GR, buf) do { ATT_WRITEK(KR, buf); \
        { LAS u32x2* vp_ = (LAS u32x2*)(lds + ATT_V_OFF + (buf) * VBx + (vrow * VPx + (VPM ? (vc >> 1) * 16 + (vc & 1) * 4 : vc * 8)) * 2); vp_[0] = (u32x2){VR.x, VR.y}; vp_[VPM ? 2 : 1] = (u32x2){VR.z, VR.w}; } \
        if (MLSTM && F.tid < 64) *(LAS float*)(lds + ATT_G_OFF + (buf) * 256 + F.tid * 4) = GR; } while (0)
#define ATT_STEP(j, buf, SC0, SC1, SN0, SN1) do { \
        if constexpr (!MLSTM && ATT_FUSED) {   \
            if ((j) <= myc) attn_step_fused<DQK, true, CIM>(lds + ATT_K_OFF + (buf) * 13312, qf, SN0, SN1, SC0, SC1, lds + ATT_V_OFF + (buf) * VBx, o, lsum, mrun, cscale, r32, hi, &negm); } \
        else { \
        if ((j) + 1 <= myc) { ATT_DBLQK(buf); attn_qk<DQK>(lds + ATT_K_OFF + (buf) * 13312, qf, SN0, SN1, r32, hi); } \
        if ((j) <= myc) attn_sm_pv<DQK, MLSTM>(SC0, SC1, lds + ATT_V_OFF + (buf) * L::VBYTES, (const LAS float*)(lds + ATT_G_OFF + (buf) * 256), o, lsum, mrun, cscale, bt2q, (j) == myc, tq, r32, hi); } } while (0)
#ifdef ATT_DBL_QK
#define ATT_DBLQK(buf) do { f32x16 t0_, t1_; attn_qk<DQK>(lds + ATT_K_OFF + (buf) * 13312, qf, t0_, t1_, r32, hi); asm volatile("" :: "v"(t0_), "v"(t1_)); } while (0)
#else
#define ATT_DBLQK(buf) do {} while (0)
#endif
    f32x16 sa0, sa1, sb0, sb1;
    ATT_LOADK(kregB, t0); ATT_LOAD(kregA, vregA, gregA, t0);
    ATT_WRITEK(kregB, 2); ATT_WRITE(kregA, vregA, gregA, 0);
    ATT_LOAD(kregA, vregA, gregA, t0 + 1);
    __syncthreads();
    attn_qk<DQK>(lds + ATT_K_OFF + 2 * 13312, qf, sa0, sa1, r32, hi);
    if constexpr (CIM) { float mx = sa0[0];
#pragma unroll
        for (int r = 1; r < 16; ++r) mx = fmaxf(mx, sa0[r]);
#pragma unroll
        for (int r = 0; r < 16; ++r) mx = fmaxf(mx, sa1[r]);
        mx = half_swap_max(mx);
#pragma unroll
        for (int r = 0; r < 16; ++r) { sa0[r] -= mx; sa1[r] -= mx; negm[r] = -mx; } }
    if (w >= 4) __builtin_amdgcn_s_setprio(1);
    for (int j = t0; j < NT; j += 2) {
        ATT_LOAD(kregB, vregB, gregB, (j + 2 < NT) ? j + 2 : NT - 1);
        ATT_STEP(j, 0, sa0, sa1, sb0, sb1);
        ATT_WRITE(kregA, vregA, gregA, 1);
        __syncthreads();
        ATT_LOAD(kregA, vregA, gregA, (j + 3 < NT) ? j + 3 : NT - 1);
        ATT_STEP(j + 1, 1, sb0, sb1, sa0, sa1);
        if (j + 2 < NT) ATT_WRITE(kregB, vregB, gregB, 0);
        __syncthreads();
    }
    __builtin_amdgcn_s_setprio(0);
#undef ATT_LOADK
#undef ATT_WRITEK
#undef ATT_LOAD
#undef ATT_WRITE
#undef ATT_STEP
}
DI void attn_pass_diff(Frame& F, const bf16* P1h  , const bf16* Vt, int b, int qb, float cscale,
                       f32x16 (&o1)[2], float& l1, f32x16 (&o2)[2], float& l2) {
    typedef AttnLds<32> L;
    int lane = F.lane; asm volatile("" : "+v"(lane));
    const int r32 = lane & 31, hi = lane >> 5, w = F.wave, tid = w * 64 + lane;
    const int NT = 4 * qb + 4, myc = 4 * qb + (w >> 1);
    LAS unsigned char* lds = F.lds;
    bf16x8 qf1[2], qf2[2];
    { const bf16* qrow = P1h + (size_t)(b * SEQ + qb * 256 + w * 32 + r32) * 1024;
#pragma unroll
      for (int ks = 0; ks < 2; ++ks) { qf1[ks] = *(const GAS bf16x8*)(qrow + ks * 16 + hi * 8); qf2[ks] = *(const GAS bf16x8*)(qrow + 128 + ks * 16 + hi * 8); } }
    o1[0] = f32x16{}; o1[1] = f32x16{}; o2[0] = f32x16{}; o2[1] = f32x16{}; l1 = 0.f; l2 = 0.f; float m1 = -INFINITY, m2 = -INFINITY;
    const int which = tid >> 8, kp = tid & 255, krow = kp >> 2, kc = kp & 3, vrow = tid >> 3, vc = tid & 7;
    const unsigned koff = (unsigned)((256 + which * 128 + krow * 1024 + kc * 8) * 2), voff = (unsigned)((vrow * NTOK + vc * 8) * 2);
    constexpr bool VPM = ATT_FUSED != 0; constexpr int VPx = VPM ? 72 : L::VP, VBx = 64 * VPx * 2;
    const unsigned kdst = (unsigned)(which * 6144 + (krow * L::KP + kc * 8) * 2), vdst = (unsigned)((vrow * VPx + (VPM ? (vc >> 1) * 16 + (vc & 1) * 4 : vc * 8)) * 2);
    const char* const wsb = (const char*)F.ws;
    const unsigned kb32 = (unsigned)((const char*)P1h - wsb) + (unsigned)b * (unsigned)(SEQ * 2048), vb32 = (unsigned)((const char*)Vt - wsb) + (unsigned)b * (unsigned)(SEQ * 2);
    u32x4 kA, vA;
#define AD_LOAD(KR, VR, j) do { KR = *(const GAS u32x4*)(wsb + (size_t)(kb32 + (unsigned)(j) * (64u * 2048u) + koff)); VR = *(const GAS u32x4*)(wsb + (size_t)(vb32 + (unsigned)(j) * 128u + voff)); } while (0)
#define AD_WRITE(KR, VR, buf) do { *(LAS u32x4*)(lds + ATT_K_OFF + (buf) * 13312 + kdst) = KR; \
        { LAS u32x2* vp_ = (LAS u32x2*)(lds + ATT_V_OFF + (buf) * VBx + vdst); vp_[0] = (u32x2){VR.x, VR.y}; vp_[VPM ? 2 : 1] = (u32x2){VR.z, VR.w}; } } while (0)
#if ATT_FUSED
#define AD_STEP(j, buf) do { if ((j) <= myc) { f32x16 s0, s1, t0, t1; \
        attn_qk<32>(lds + ATT_K_OFF + (buf) * 13312, qf1, s0, s1, r32, hi); \
        attn_step_fused<32, true>(lds + ATT_K_OFF + (buf) * 13312 + 6144, qf2, t0, t1, s0, s1, lds + ATT_V_OFF + (buf) * VBx, o1, l1, m1, cscale, r32, hi);     \
        attn_step_fused<32, false>(lds, qf2, s0, s1, t0, t1, lds + ATT_V_OFF + (buf) * VBx, o2, l2, m2, cscale, r32, hi); } } while (0)
#else
#define AD_STEP(j, buf) do { if ((j) <= myc) { f32x16 s0, s1; \
        attn_qk<32>(lds + ATT_K_OFF + (buf) * 13312, qf1, s0, s1, r32, hi); \
        attn_sm_pv<32, false>(s0, s1, lds + ATT_V_OFF + (buf) * L::VBYTES, nullptr, o1, l1, m1, cscale, 0.f, false, 0, r32, hi); \
        attn_qk<32>(lds + ATT_K_OFF + (buf) * 13312 + 6144, qf2, s0, s1, r32, hi); \
        attn_sm_pv<32, false>(s0, s1, lds + ATT_V_OFF + (buf) * L::VBYTES, nullptr, o2, l2, m2, cscale, 0.f, false, 0, r32, hi); } } while (0)
#endif
    AD_LOAD(kA, vA, 0); AD_WRITE(kA, vA, 0);
    __syncthreads();
    if (w >= 4) __builtin_amdgcn_s_setprio(1);
    for (int j = 0; j < NT; j += 2) {
        AD_LOAD(kA, vA, j + 1);
        AD_STEP(j, 0);
        AD_WRITE(kA, vA, 1);
        __syncthreads();
        AD_LOAD(kA, vA, (j + 2 < NT) ? j + 2 : NT - 1);
        AD_STEP(j + 1, 1);
        if (j + 2 < NT) AD_WRITE(kA, vA, 0);
        __syncthreads();
    }
    __builtin_amdgcn_s_setprio(0);
#undef AD_LOAD
#undef AD_WRITE
#undef AD_STEP
}
DI void attn_store(bf16* orow, int hi, const f32x16 (&v)[2]) {
#pragma unroll
    for (int d = 0; d < 2; ++d)
#pragma unroll
        for (int g = 0; g < 4; ++g) { u32x2 w; w.x = cvtpk(v[d][4 * g], v[d][4 * g + 1]); w.y = cvtpk(v[d][4 * g + 2], v[d][4 * g + 3]); *(GAS u32x2*)(orow + 32 * d + 8 * g + 4 * hi) = w; }
}
constexpr int MS_K = 0, MS_V = 36864, MS_G = 71680, MS_RED = 0, MS_REDN = 65536;
DI void mlstm_state_unit(Frame& F, int bh, int blk) {
    const int b = bh / 6, h = bh % 6, lane = F.lane, r32 = lane & 31, hi = lane >> 5, w = F.wave, p = w >> 1, dh = w & 1, ptid = F.tid & 127, tl = 4 * blk + p;
    LAS unsigned char* lds = F.lds;
    const bf16* kbc = (const bf16*)(F.ws + WS_KBC) + (size_t)(b * SEQ + tl * 64) * 384 + h * 64;
    const bf16* vt = (const bf16*)(F.ws + WS_VTAB) + (size_t)(256 + h * 64) * NTOK + b * SEQ + tl * 64;
    const float* bt2 = (const float*)(F.ws + WS_BT2) + (size_t)bh * SEQ; const float* a2 = (const float*)(F.ws + WS_A2) + (size_t)bh * SEQ;
    { u32x4 kr[4], vr[4];
#pragma unroll
      for (int i = 0; i < 4; ++i) { const int q = ptid + 128 * i, row = q >> 3, c = q & 7; kr[i] = *(const GAS u32x4*)(kbc + (size_t)row * 384 + c * 8); vr[i] = *(const GAS u32x4*)(vt + (size_t)row * NTOK + c * 8); }
      const float g = (ptid < 64) ? a2[tl * 64 + ptid] : 0.f;
#pragma unroll
      for (int i = 0; i < 4; ++i) { const int q = ptid + 128 * i, row = q >> 3, c = q & 7;
          *(LAS u32x4*)(lds + MS_K + p * 9216 + (row * 72 + c * 8) * 2) = kr[i];
          LAS u32x2* vp = (LAS u32x2*)(lds + MS_V + p * 8704 + (row * 68 + c * 8) * 2); vp[0] = (u32x2){vr[i].x, vr[i].y}; vp[1] = (u32x2){vr[i].z, vr[i].w}; }
      if (ptid < 64) *(LAS float*)(lds + MS_G + p * 256 + ptid * 4) = g; }
    __syncthreads();
    bf16x8 qf[4]; const int col = 32 * dh + r32;
#pragma unroll
    for (int ks = 0; ks < 4; ++ks)
#pragma unroll
        for (int j = 0; j < 8; ++j) qf[ks][j] = (16 * ks + 8 * hi + j == col) ? (short)0x3F80 : (short)0;
    f32x16 s0, s1, o[2]; o[0] = f32x16{}; o[1] = f32x16{}; float lsum = 0.f, mrun = 0.f;
    attn_qk<64>(lds + MS_K + p * 9216, qf, s0, s1, r32, hi);
    attn_sm_pv<64, true>(s0, s1, lds + MS_V + p * 8704, (const LAS float*)(lds + MS_G + p * 256), o, lsum, mrun, 0.f, bt2[blk * 256 + 255], false, 0, r32, hi);
    lsum = half_swap_sum(lsum);
    __syncthreads();
    LAS float* red = (LAS float*)(lds + MS_RED) + p * 4096; LAS float* redn = (LAS float*)(lds + MS_REDN) + p * 64;
#pragma unroll
    for (int d = 0; d < 2; ++d)
#pragma unroll
        for (int r = 0; r < 16; ++r) red[(32 * d + (r & 3) + 8 * (r >> 2) + 4 * hi) * 64 + col] = o[d][r];
    if (hi == 0) redn[col] = lsum;
    __syncthreads();
    { const LAS f32x4* r4 = (const LAS f32x4*)(lds + MS_RED) + F.tid * 2; f32x4 a0 = r4[0], a1 = r4[1];
#pragma unroll
      for (int q = 1; q < 4; ++q) { a0 += r4[q * 1024]; a1 += r4[q * 1024 + 1]; }
      GAS f32x4* dc = (GAS f32x4*)((float*)(F.ws + WS_DC) + ((size_t)bh * 7 + blk) * 4096) + F.tid * 2; dc[0] = a0; dc[1] = a1;
      if (F.tid < 64) { const LAS float* rn = (const LAS float*)(lds + MS_REDN) + F.tid; ((float*)(F.ws + WS_DN))[((size_t)bh * 7 + blk) * 64 + F.tid] = (rn[0] + rn[64]) + (rn[128] + rn[192]); } }
    __syncthreads();
}
DI void mlstm_state_phase(Frame& F) { for (int u = F.cu; u < 96 * 7; u += F.G) mlstm_state_unit(F, u / 7, u % 7); }
constexpr int MS_CS = 65536, MS_NS = 65536 + 9216;
DI void mlstm_inter(Frame& F, int bh, int qb, const bf16* qrow  , float bt2q, f32x16 (&o)[2], float& den) {
    int lane = F.lane; asm volatile("" : "+v"(lane));
    const int r32 = lane & 31, hi = lane >> 5, tid = F.wave * 64 + lane;
    LAS unsigned char* lds = F.lds;
    const float* bt2 = (const float*)(F.ws + WS_BT2) + (size_t)bh * SEQ;
    const float bref = bt2[qb * 256 - 1];
    { const int dv = tid >> 3, dk0 = (tid & 7) * 8; f32x4 c0 = {0.f, 0.f, 0.f, 0.f}, c1 = c0; float nacc = 0.f;
      for (int b0 = 0; b0 < qb; b0 += 4) { float bend[4]; f32x4 d0[4], d1[4]; float dnv[4];
#pragma unroll
          for (int i = 0; i < 4; ++i) { const int blk = (b0 + i < qb) ? b0 + i : qb - 1;
              bend[i] = bt2[blk * 256 + 255];
              const GAS f32x4* dc = (const GAS f32x4*)((const float*)(F.ws + WS_DC) + ((size_t)bh * 7 + blk) * 4096 + dv * 64 + dk0); d0[i] = dc[0]; d1[i] = dc[1];
              dnv[i] = (tid < 64) ? ((const float*)(F.ws + WS_DN))[((size_t)bh * 7 + blk) * 64 + tid] : 0.f; }
#pragma unroll
          for (int i = 0; i < 4; ++i) { const float d = (b0 + i < qb) ? __builtin_amdgcn_exp2f(bref - bend[i]) : 0.f; c0 += d0[i] * d; c1 += d1[i] * d; nacc += dnv[i] * d; } }
      u32x4 wv; wv.x = cvtpk(c0.x, c0.y); wv.y = cvtpk(c0.z, c0.w); wv.z = cvtpk(c1.x, c1.y); wv.w = cvtpk(c1.z, c1.w);
      *(LAS u32x4*)(lds + MS_CS + (dv * 72 + dk0) * 2) = wv;
      if (tid < 64) *(LAS float*)(lds + MS_NS + tid * 4) = nacc; }
    __syncthreads();
    bf16x8 qf[4];
#pragma unroll
    for (int ks = 0; ks < 4; ++ks) qf[ks] = *(const GAS bf16x8*)(qrow + ks * 16 + hi * 8);
    f32x16 i0, i1; attn_qk<64>(lds + MS_CS, qf, i0, i1, r32, hi);
    float dn = 0.f;
#pragma unroll
    for (int ks = 0; ks < 4; ++ks) { const f32x4 n0 = *(const LAS f32x4*)(lds + MS_NS + (16 * ks + 8 * hi) * 4), n1 = *(const LAS f32x4*)(lds + MS_NS + (16 * ks + 8 * hi + 4) * 4);
#pragma unroll
        for (int j = 0; j < 4; ++j) dn += bf2f((unsigned short)qf[ks][j]) * n0[j] + bf2f((unsigned short)qf[ks][4 + j]) * n1[j]; }
    dn = half_swap_sum(dn);
    const float u = __builtin_amdgcn_exp2f(bt2q - bref);
#pragma unroll
    for (int r = 0; r < 16; ++r) { o[0][r] += u * i0[r]; o[1][r] += u * i1[r]; }
    den += u * dn;
}
DI void attn_unit(Frame& F, KArgs a, int l, int mode, int bh, int qb) {
    const bf16* P1 = (const bf16*)(F.ws + WS_P1); bf16* mix = (bf16*)(F.ws + WS_HB);
    const int lane = F.lane, r32 = lane & 31, hi = lane >> 5;
    f32x16 o[2]; float lsum;
    if (mode == 0) {
        const int b = bh >> 2, h = bh & 3; const size_t row = (size_t)b * SEQ + qb * 256 + F.wave * 32 + r32;
        const bf16* Vt = (const bf16*)(F.ws + WS_VTAB) + (size_t)(h * 64) * NTOK; const float cs = 0.17677669529663687f * LOG2E;
        f32x16 o1[2]; float lsum1;
        attn_pass_diff(F, P1 + h * 32, Vt, b, qb, cs, o1, lsum1, o, lsum);
        { const float inv = 1.f / half_swap_sum(lsum1);
#pragma unroll
          for (int d = 0; d < 2; ++d)
#pragma unroll
              for (int r = 0; r < 16; ++r) o1[d][r] *= inv; }
        float d1 = 0.f, d2 = 0.f;
        { const float* q1 = IN(I_LQ1) + l * 32, *k1 = IN(I_LK1) + l * 32, *q2 = IN(I_LQ2) + l * 32, *k2 = IN(I_LK2) + l * 32;
#pragma unroll 8
          for (int i = 0; i < 32; ++i) { d1 += q1[i] * k1[i]; d2 += q2[i] * k2[i]; } }
        const float lam_init = 0.8f - 0.6f * __expf(-0.3f * (float)l), lam = __expf(d1) - __expf(d2) + lam_init;
        const float inv2 = lam / half_swap_sum(lsum); float ss = 0.f;
#pragma unroll
        for (int d = 0; d < 2; ++d)
#pragma unroll
            for (int r = 0; r < 16; ++r) { o[d][r] = o1[d][r] - o[d][r] * inv2; ss += o[d][r] * o[d][r]; }
        const float rstd = rsqrtf(half_swap_sum(ss) * (1.f / 64.f) + EPS) * (1.f - lam_init); const float* gd = IN(I_GDIFF) + l * 64;
#pragma unroll
        for (int d = 0; d < 2; ++d)
#pragma unroll
            for (int g = 0; g < 4; ++g) { const f32x4 gg = *(const GAS f32x4*)(gd + 32 * d + 8 * g + 4 * hi);
#pragma unroll
                for (int q = 0; q < 4; ++q) o[d][4 * g + q] *= rstd * gg[q]; }
        attn_store(mix + row * D + h * 64, hi, o);
    } else if (mode == 1) {
        const int b = bh / 6, h = bh % 6; const size_t row = (size_t)b * SEQ + qb * 256 + F.wave * 32 + r32;
        const bf16* Vt = (const bf16*)(F.ws + WS_VTAB) + (size_t)(256 + h * 64) * NTOK;
        const float* bt2 = (const float*)(F.ws + WS_BT2) + (size_t)bh * SEQ; const float* a2 = (const float*)(F.ws + WS_A2) + (size_t)bh * SEQ;
        const float bt2q = bt2[qb * 256 + F.wave * 32 + r32];
        attn_pass<64, true>(F, (const bf16*)(F.ws + WS_QBC) + h * 64, 384, (const bf16*)(F.ws + WS_KBC) + h * 64, 384, Vt, a2, bt2q, b, qb, 0.f, o, lsum, 4 * qb);
        float den = half_swap_sum(lsum);
        if (qb > 0) mlstm_inter(F, bh, qb, (const bf16*)(F.ws + WS_QBC) + row * 384 + h * 64, bt2q, o, den);
        const float inv = 1.f / fmaxf(fabsf(den), 1.f); float ss = 0.f;
#pragma unroll
        for (int d = 0; d < 2; ++d)
#pragma unroll
            for (int r = 0; r < 16; ++r) { o[d][r] *= inv; ss += o[d][r] * o[d][r]; }
        const float rstd = rsqrtf(half_swap_sum(ss) * (1.f / 64.f) + EPS); const float* gm = IN(I_GML) + l * 384 + h * 64; const bf16* ob = P1 + row * 1024 + 512 + h * 64;
#pragma unroll
        for (int d = 0; d < 2; ++d)
#pragma unroll
            for (int g = 0; g < 4; ++g) { const int dv = 32 * d + 8 * g + 4 * hi; const f32x4 gg = *(const GAS f32x4*)(gm + dv); const u32x2 ow = *(const GAS u32x2*)(ob + dv);
                const float og[4] = {bflo(ow.x), bfhi(ow.x), bflo(ow.y), bfhi(ow.y)};
#pragma unroll
                for (int q = 0; q < 4; ++q) o[d][4 * g + q] *= rstd * gg[q] * sigmoidf_(og[q]); }
        attn_store(mix + row * D + 256 + h * 64, hi, o);
    } else {
        const int b = bh / 6, h = bh % 6; const size_t row = (size_t)b * SEQ + qb * 256 + F.wave * 32 + r32;
        const bf16* Vt = (const bf16*)(F.ws + WS_VTC) + (size_t)(h * 64) * NTOK;
        attn_pass<96, false>(F, (const bf16*)(F.ws + WS_QC) + h * 96, 576, (const bf16*)(F.ws + WS_KC) + h * 96, 576, Vt, nullptr, 0.f, b, qb, 0.10206207261596577f * LOG2E, o, lsum);
        const float inv = 1.f / half_swap_sum(lsum);
#pragma unroll
        for (int d = 0; d < 2; ++d)
#pragma unroll
            for (int r = 0; r < 16; ++r) o[d][r] *= inv;
        attn_store(mix + row * D + 640 + h * 64, hi, o);
    }
}
DI void phase_attn(Frame& F, KArgs a, int l, int rep = 0) {
    volatile LAS int* slot = (volatile LAS int*)(F.lds + MISC_OFF + 256);
    for (;;) {
        __syncthreads();
        if (F.tid == 0) slot[0] = (int)__hip_atomic_fetch_add((unsigned*)(F.ctl + CW_ATTQ + 64 * l + 16 * rep), 1u, __ATOMIC_RELAXED, __HIP_MEMORY_SCOPE_AGENT);
        __syncthreads();
        int i = slot[0];
        if (l == 0) {
            if (i >= 2048 + TR_MOE_CHUNKS) break;
            if (i < 4 * TR_MOE_CHUNKS) {
                if (i % 4 == 3) { const int c = i / 4;
                    tr_run(F, a, TR_N_EARLY + c * TR_MOE_CHUNK + F.wave, TR_N_EARLY + (c + 1) * TR_MOE_CHUNK, NWAVES, (LAS float*)(F.lds + F.wave * 16384));
                    continue; }
                i -= i / 4; }
            else i -= TR_MOE_CHUNKS; }
        if (i >= 2048) break;
        const int qb = 7 - (i >> 8), j = i & 255;
        if (j < 96) attn_unit(F, a, l, 2, j, qb); else if (j < 160) attn_unit(F, a, l, 0, j - 96, qb); else attn_unit(F, a, l, 1, j - 160, qb);
    }
}

constexpr int PH_LAYER0 = 2, PH_STRIDE = 20, N_PHASES = PH_LAYER0 + PH_STRIDE * DEPTH;
DI pg8::Job mkjob(const bf16* A, const bf16* Bt, int lda, int ldb, int K, int nM, int nN, int epi, bf16* O, int ldc) {
    pg8::Job J; J.A = A; J.Bt = Bt; J.lda = lda; J.ldb = ldb; J.K = K; J.nM = nM; J.nN = nN; J.sched = pg8::SCH_STATIC; J.rot = 0; J.epi = epi; J.O = O; J.ldc = ldc; J.row_limit = 0x7fffffff; J.split_cols = 0; J.split_stride = 0;
    J.cs = nullptr; J.glist = nullptr; J.gather = 0; J.tile0 = 0; J.bexp_rows = 0; return J;
}
DI bool phase_active(int p) {
    if (p < PH_LAYER0) return true;
    const int l = (p - PH_LAYER0) / PH_STRIDE, r = (p - PH_LAYER0) % PH_STRIDE;
    if (r <= 5 || r == 16) return true;
    if (r <= 7) return true;
    return (l & 1) && r < 6 + 2 * MOE_MAX_CHUNKS;
}
DI int phase_njobs(int p) {
    if (p < PH_LAYER0) return 0;
    const int l = (p - PH_LAYER0) / PH_STRIDE, r = (p - PH_LAYER0) % PH_STRIDE;
    if (r == 0) return 2; if (r == 2) return 3; if (r == 4) return 1;
    if (r >= 6 && r < 16) return 1;
    (void)l; return 0;
}
DI bool get_job(Frame& F, const LAS int* mm, int p, int jj, pg8::Job& J) {
    unsigned char* ws = F.ws; const bf16* HB = (const bf16*)(ws + WS_HB);
    const int l = (p - PH_LAYER0) / PH_STRIDE, r = (p - PH_LAYER0) % PH_STRIDE;
    if (r == 0) {
        if (jj == 0) { J = mkjob(HB, (const bf16*)(ws + WS_WIN) + (size_t)l * 2048 * 1024, 1024, 1024, 1024, NTOK / 256, 8, pg8::EPI_STORE, (bf16*)(ws + WS_P1), 1024); J.split_cols = 1024; J.split_stride = (long)((WS_P2 - WS_P1) / 2); }
        else { J = mkjob((const bf16*)(ws + WS_WV) + (size_t)l * 768 * 1024, HB, 1024, 1024, 1024, 3, NTOK / 256, pg8::EPI_STORE, (bf16*)(ws + WS_VTAB), NTOK); J.row_limit = 640; J.rot = 128; }
        return true; }
    if (r == 2) {
        if (jj == 0) { J = mkjob((const bf16*)(ws + WS_CQN), (const bf16*)(ws + WS_WUQ) + (size_t)l * 768 * 256, 256, 256, 256, NTOK / 256, 3, pg8::EPI_ROPEQ, (bf16*)(ws + WS_QC), 576); J.cs = (const float*)(ws + WS_CS); }
        else if (jj == 1) { J = mkjob((const bf16*)(ws + WS_CKVN), (const bf16*)(ws + WS_WUKK) + (size_t)l * 512 * 128, 128, 128, 128, NTOK / 256, 2, pg8::EPI_KNOPE, (bf16*)(ws + WS_KC), 576); J.rot = 128; }
        else { J = mkjob((const bf16*)(ws + WS_WUKV) + (size_t)l * 512 * 128, (const bf16*)(ws + WS_CKVN), 128, 128, 128, 2, NTOK / 256, pg8::EPI_STORE, (bf16*)(ws + WS_VTC), NTOK); J.row_limit = 384; }
        return true; }
    if (r == 4) { J = mkjob(HB, (const bf16*)(ws + WS_WOUT) + (size_t)l * D * D, 1024, 1024, 1024, NTOK / 256, 4, pg8::EPI_STORE, (bf16*)(ws + WS_Y), 1024); return true; }
    if (!(l & 1)) {
#if DENSE_FP8 == 2
        if (r == 6) { J = mkjob((const bf16*)(ws + WS_H8), (const bf16*)(ws + WS_WGUD), 1024, 1024, 1024, NTOK / 256, 28, pg8::EPI_SWIGLU, (bf16*)(ws + WS_ACT), DFF); J.gather = 8; }
        else J = mkjob((const bf16*)(ws + WS_ACT), (const bf16*)(ws + WS_WDD), DFF, DFF, DFF, NTOK / 256, 4, pg8::EPI_STORE, (bf16*)(ws + WS_Y2), 1024);
#elif DENSE_FP8
        if (r == 6) J = mkjob((const bf16*)(ws + WS_H8), (const bf16*)(ws + WS_WGUD), 1024, 1024, 1024, NTOK / 256, 28, pg8::EPI_SWIGLU8, (bf16*)(ws + WS_ACT), DFF);
        else { J = mkjob((const bf16*)(ws + WS_ACT), (const bf16*)(ws + WS_WDD), DFF, DFF, DFF, NTOK / 256, 4, pg8::EPI_STORE, (bf16*)(ws + WS_Y2), 1024); J.gather = 8; }
#else
        if (r == 6) J = mkjob(HB, (const bf16*)(ws + WS_WGUD), 1024, 1024, 1024, NTOK / 256, 28, pg8::EPI_SWIGLU, (bf16*)(ws + WS_ACT), DFF);
        else J = mkjob((const bf16*)(ws + WS_ACT), (const bf16*)(ws + WS_WDD), DFF, DFF, DFF, NTOK / 256, 4, pg8::EPI_STORE, (bf16*)(ws + WS_Y2), 1024);
#endif
        return true; }
    const int c = (r - 6) >> 1; const bool up = !((r - 6) & 1);
    __syncthreads();
    if (F.tid < 8) { LAS int* mw = (LAS int*)mm;
        const int cnt = (int)__hip_atomic_load((unsigned*)(F.ctl + CW_MOECNT + F.tid), __ATOMIC_RELAXED, __HIP_MEMORY_SCOPE_AGENT);
        const int tiles = (cnt + 255) >> 8; int incl = tiles;
#pragma unroll
        for (int o = 1; o < 8; o <<= 1) { const int t = __builtin_amdgcn_ds_bpermute((F.tid - o) << 2, incl); if (F.tid >= o) incl += t; }
        mw[F.tid] = incl - tiles; mw[9 + F.tid] = cnt; if (F.tid == 7) mw[8] = incl; }
    __syncthreads();
    const int total = mm[8]; const int t0 = c * MOE_CHUNK_TILES; int nt = total - t0; if (nt > MOE_CHUNK_TILES) nt = MOE_CHUNK_TILES;
    if (nt <= 0) return false;
    if (up) { J = mkjob((const bf16*)(ws + WS_H8), (const bf16*)(ws + WS_WGUE), 1024, 1024, 1024, nt, 28, pg8::EPI_SWIGLU8, (bf16*)(ws + WS_ACT), DFF); J.gather = 1; J.bexp_rows = 7168; }
    else { J = mkjob((const bf16*)(ws + WS_ACT), (const bf16*)(ws + WS_WDE), DFF, DFF, DFF, nt, 4, pg8::EPI_SCATTER, (bf16*)(ws + WS_YM), 1024); J.bexp_rows = 1024; J.cs = (const float*)(ws + WS_DC); }
    J.sched = pg8::SCH_MOE; J.glist = (const int*)(ws + WS_LIST); J.tile0 = t0;
    return true;
}
#ifndef DBG_MASK
#define DBG_MASK 0xffff
#endif
#define DBG_ON(k) ((DBG_MASK >> (k)) & 1)
template <int KIND> DI void run_phase(Frame& F, KArgs a, int p, int rep, const XcdBarrier& bar, int wave0) {
    LAS int* mm = (LAS int*)(F.lds + MISC_OFF + 512);
    const int nj = phase_njobs(p);
    if constexpr (KIND == -1) { if (p >= PH_LAYER0 && (p - PH_LAYER0) % PH_STRIDE == 2) { RELANE(F); mlstm_state_phase(F); } }
    if (nj > 0) {
        if constexpr (KIND == -1 || KIND >= 10) {
            for (int jj = 0; jj < nj; ++jj) { pg8::Job J; RELANE(F);
                if (get_job(F, mm, p, jj, J)) {
                if (J.epi == pg8::EPI_STORE) { if (J.gather == 8) { if constexpr (DENSE_FP8 == 1 && (KIND == -1 || KIND == 16)) pg8::gemm_phase<pg8::EPI_STORE, false, true>(F.lds, mm, J, F.G, (int)blockIdx.x, F.wave);     }
                                               else { if constexpr (KIND == -1 || KIND == 10) pg8::gemm_phase<pg8::EPI_STORE, false>(F.lds, mm, J, F.G, (int)blockIdx.x, F.wave);     } }
                else if (J.epi == pg8::EPI_ROPEQ) { if constexpr (KIND == -1 || KIND == 11) pg8::gemm_phase<pg8::EPI_ROPEQ, false>(F.lds, mm, J, F.G, (int)blockIdx.x, F.wave);     }
                else if (J.epi == pg8::EPI_KNOPE) { if constexpr (KIND == -1 || KIND == 12) pg8::gemm_phase<pg8::EPI_KNOPE, false>(F.lds, mm, J, F.G, (int)blockIdx.x, F.wave);     }
                else if (J.epi == pg8::EPI_SWIGLU8) { if (J.sched == pg8::SCH_MOE) { if constexpr (KIND == -1 || KIND == 14) pg8::gemm_phase<pg8::EPI_SWIGLU8, true, true>(F.lds, mm, J, F.G, (int)blockIdx.x, F.wave);     }
                                                      else { if constexpr (DENSE_FP8 == 1 && (KIND == -1 || KIND == 13)) pg8::gemm_phase<pg8::EPI_SWIGLU8, false, true>(F.lds, mm, J, F.G, (int)blockIdx.x, F.wave);     } }
                else if (J.epi == pg8::EPI_SWIGLU && J.gather == 8) { if constexpr (DENSE_FP8 == 2 && (KIND == -1 || KIND == 13)) pg8::gemm_phase<pg8::EPI_SWIGLU, false, true>(F.lds, mm, J, F.G, (int)blockIdx.x, F.wave); }
                else if (J.epi == pg8::EPI_SWIGLU) { if constexpr (!DENSE_FP8 && (KIND == -1 || KIND == 13)) pg8::gemm_phase<pg8::EPI_SWIGLU, false>(F.lds, mm, J, F.G, (int)blockIdx.x, F.wave);     }
                else { if constexpr (KIND == -1 || KIND == 15) pg8::gemm_phase<pg8::EPI_SCATTER, true, true>(F.lds, mm, J, F.G, (int)blockIdx.x, F.wave);     } } } }
        if constexpr (KIND == -1) { if (p == PH_LAYER0 && F.G == 256 && (int)blockIdx.x < 128) {
            RELANE(F); __syncthreads(); tr_run(F, a, TR_N_SMALL + (int)blockIdx.x * NWAVES + F.wave, TR_N_EARLY, 128 * NWAVES, (LAS float*)(F.lds + F.wave * 16384)); } }
        return; }
    if (p == 0) { if constexpr (KIND == -1 || KIND == 0) { RELANE(F); p0_prologue(F, a); } return; }
    if (p == 1) { if constexpr (KIND == -1 || KIND == 1) { RELANE(F); phase_row0(F, a); } return; }
    const int l = (p - PH_LAYER0) / PH_STRIDE, r = (p - PH_LAYER0) % PH_STRIDE;
    if (r == 1) { if constexpr (KIND == -1 || KIND == 2) { RELANE(F); phase_fix(F, a, l);
        } }
    else if (r == 3) { if constexpr (KIND == -1 || KIND == 3) { RELANE(F); phase_attn(F, a, l, rep); } }
    else if (r == 5) { if constexpr (KIND == -1 || KIND == 4) { RELANE(F); phase_row1(F, a, l); } }
    else if (r == 16) { if constexpr (KIND == -1 || KIND == 5) { RELANE(F); phase_row2(F, a, l); } }
}

template <int KIND> __global__ void __launch_bounds__(NTHR, 2) mk_fwd(Args args) {
    extern __shared__ __attribute__((aligned(16))) unsigned char lds[];
    KArgs ka = (KArgs)__builtin_amdgcn_kernarg_segment_ptr();
    Frame F;
    F.lds = (LAS unsigned char*)lds; F.MISC = (volatile LAS unsigned*)(F.lds + MISC_OFF);
    F.tid = threadIdx.x; F.lane = F.tid & 63; F.wave = __builtin_amdgcn_readfirstlane(F.tid >> 6);
    F.G = gridDim.x; { const int bx = blockIdx.x; F.cu = (F.G % 8 == 0) ? (bx % 8) * (F.G / 8) + bx / 8 : bx; }
    F.ws = ka->ws; F.out = ka->out; F.ctl = (gu32*)(F.ws + WS_CTL);
    for (int u = F.tid; u < (LDS_BYTES - MISC_OFF) / 4; u += NTHR) ((LAS unsigned*)(F.lds + MISC_OFF))[u] = 0u;
    __syncthreads();
    if constexpr (KIND == -1) {
        XcdBarrier bar = xcd_barrier_post((unsigned*)(F.ctl + CW_BAR), F.MISC + 8, F.tid == 0);
        const int wave0 = F.wave;
        const int lo = ka->ph_lo, hi = ka->ph_hi;
        for (int p = lo; p < hi; ++p) {
            if (!phase_active(p)) continue;
            { int wv = wave0; asm volatile("" : "+s"(wv)); F.wave = wv; RELANE(F);
              KArgs k2 = ka; asm volatile("" : "+s"(k2)); F.ws = k2->ws; F.out = k2->out; F.ctl = (gu32*)(F.ws + WS_CTL);
              run_phase<-1>(F, k2, p, 0, bar, wave0); }
            xcd_barrier(bar, wave0);
#ifdef EXTRA_BAR
            xcd_barrier(bar, wave0);
#endif
#ifdef REP_MASK
            { const int r_ = (p - PH_LAYER0) % PH_STRIDE, l_ = (p - PH_LAYER0) / PH_STRIDE; int cls = -1;
              if (p == 0) cls = 0; else if (p >= PH_LAYER0) { if (r_ == 0) cls = 1; else if (r_ == 1) cls = 2; else if (r_ == 2) cls = 3; else if (r_ == 3) cls = 4; else if (r_ == 4) cls = 5;
                  else if (r_ >= 6 && r_ < 16) cls = (l_ & 1) ? 7 : 6; }
              if (cls >= 0 && ((REP_MASK >> cls) & 1)) { KArgs k3 = ka; asm volatile("" : "+s"(k3)); run_phase<-1>(F, k3, p, 1, bar, wave0); xcd_barrier(bar, wave0); } }
#endif
        }
    } else {
        { XcdBarrier nb; nb.bar = nullptr; nb.x = 0; nb.st = nullptr; run_phase<KIND>(F, ka, ka->ph_lo, 0, nb, 0); }
    }
    (void)args;
}
#if MK_SINGLE
#define MK_KERNELS(X) X(-1)
#else
#define MK_KERNELS(X) X(0) X(1) X(2) X(3) X(4) X(5) X(10) X(11) X(12) X(13) X(14) X(15)
#endif
static int phase_kinds(int p, int* kinds) {
    if (p == 0) { kinds[0] = 0; return 1; } if (p == 1) { kinds[0] = 1; return 1; }
    const int l = (p - PH_LAYER0) / PH_STRIDE, r = (p - PH_LAYER0) % PH_STRIDE;
    if (r == 0) { kinds[0] = 10; return 1; } if (r == 1) { kinds[0] = 2; return 1; } if (r == 2) { kinds[0] = 11; kinds[1] = 12; kinds[2] = 10; return 3; }
    if (r == 3) { kinds[0] = 3; return 1; } if (r == 4) { kinds[0] = 10; return 1; } if (r == 5) { kinds[0] = 4; return 1; } if (r == 16) { kinds[0] = 5; return 1; }
    if (!(l & 1)) { if (r == 6) { kinds[0] = 13; return 1; } if (r == 7) { kinds[0] = 10; return 1; } return 0; }
    if (r >= 6 && r < 16) { kinds[0] = ((r - 6) & 1) ? 15 : 14; return 1; }
    return 0;
}
template <int KIND> static void launch_kind(int grid, hipStream_t stream, const Args& a) { hipLaunchKernelGGL(mk_fwd<KIND>, dim3(grid), dim3(NTHR), LDS_BYTES, stream, a); }
template <int KIND> static bool set_attr() { return hipFuncSetAttribute((const void*)mk_fwd<KIND>, hipFuncAttributeMaxDynamicSharedMemorySize, LDS_BYTES) == hipSuccess; }

extern "C" void kernel_launch(void* const* d_in, const int* in_sizes, int n_in, void* d_out, int out_size, void* d_ws, size_t ws_size, hipStream_t stream) {
    static int grid = 0;
    if (grid == 0) {
        if (n_in != 30 || out_size != NTOK * D || ws_size < WS_END) { fprintf(stderr, "kernel_launch: unexpected shapes (n_in %d out %d ws %zu)\n", n_in, out_size, ws_size); grid = -1; return; }
        int dev = 0, cus = 0;
        if (hipGetDevice(&dev) != hipSuccess || hipDeviceGetAttribute(&cus, hipDeviceAttributeMultiprocessorCount, dev) != hipSuccess) { grid = -1; return; }
        bool ok = true;
#define X(k) ok = ok && set_attr<k>();
        MK_KERNELS(X)
#undef X
        if (!ok) { fprintf(stderr, "kernel_launch: hipFuncSetAttribute failed\n"); grid = -1; return; }
        (void)hipGetLastError();
        grid = cus;
    }
    if (grid < 0) return;
    (void)hipMemsetAsync((char*)d_ws + WS_CTL, 0, CTL_ZERO_BYTES, stream);
    Args a{};
    for (int i = 0; i < 30; ++i) a.in[i] = d_in[i];
    a.out = (float*)d_out; a.ws = (unsigned char*)d_ws;
#if MK_SINGLE
    a.ph_lo = 0; a.ph_hi = N_PHASES;
    launch_kind<-1>(grid, stream, a);
#else
    for (int p = 0; p < N_PHASES; ++p) {
        int kinds[4]; const int nk = phase_kinds(p, kinds);
        a.ph_lo = p; a.ph_hi = p + 1;
        for (int i = 0; i < nk; ++i) {
            switch (kinds[i]) {
#define X(k) case k: launch_kind<k>(grid, stream, a); break;
                MK_KERNELS(X)
#undef X
            }
        }
    }
#endif
}
```

```cpp
#include <hip/hip_runtime.h>
#include <cstdio>
#include <cstdint>

#ifndef MK_SINGLE
#ifndef ATT_FUSED
#define ATT_FUSED 1
#endif
#ifndef ATT_CINIT
#define ATT_CINIT 1
#endif
#define MLA_QSCALE_ON (ATT_FUSED && ATT_CINIT)
#define ATT_CINIT 0
#define MK_SINGLE 1
#endif

#define GAS __attribute__((address_space(1)))
#define LAS __attribute__((address_space(3)))
#define DI __device__ __forceinline__
typedef unsigned short bf16;
typedef short bf16x8 __attribute__((ext_vector_type(8)));
typedef short s16x4 __attribute__((ext_vector_type(4)));
typedef float f32x2 __attribute__((ext_vector_type(2)));
typedef float f32x4 __attribute__((ext_vector_type(4)));
typedef float f32x16 __attribute__((ext_vector_type(16)));
typedef unsigned u32x2 __attribute__((ext_vector_type(2)));
typedef unsigned u32x4 __attribute__((ext_vector_type(4)));
typedef int i32x8 __attribute__((ext_vector_type(8)));
typedef short s16x16 __attribute__((ext_vector_type(16)));
typedef __bf16 bf16x2_t __attribute__((ext_vector_type(2)));
typedef GAS unsigned gu32;

constexpr int D = 1024, BATCH = 16, SEQ = 2048, NTOK = BATCH * SEQ, DEPTH = 2;
constexpr int INW = 2668, DFF = 3584, NEXP = 8;
constexpr float EPS = 1e-6f;
constexpr int NWAVES = 8, NTHR = 512;
constexpr float LOG2E = 1.4426950408889634f;
constexpr float MLA_QSCALE = MLA_QSCALE_ON ? 0.10206207261596577f * 1.4426950408889634f : 1.f;

constexpr size_t MiB = 1u << 20;
constexpr size_t WS_CTL = 0, CTL_ZERO_BYTES = 32768;
constexpr size_t WS_MOD = 1 * MiB;
constexpr size_t WS_CS = 2 * MiB;
constexpr size_t WS_BT2 = 6 * MiB;
constexpr size_t WS_A2 = WS_BT2 + 768 * 1024;
constexpr size_t WS_GATE = 7 * MiB + 768 * 1024;
constexpr size_t WS_LIST = 8 * MiB;
constexpr size_t WS_WIN = 9 * MiB;
constexpr size_t WS_WV = WS_WIN + 8 * MiB;
constexpr size_t WS_WOUT = WS_WV + 3 * MiB;
constexpr size_t WS_WUQ = WS_WOUT + 4 * MiB;
constexpr size_t WS_WUKK = WS_WUQ + 768 * 1024;
constexpr size_t WS_WUKV = WS_WUKK + 256 * 1024;
constexpr size_t WS_WGUD = WS_WUKV + 256 * 1024;
constexpr size_t WS_WDD = WS_WGUD + 14 * MiB;
constexpr size_t WS_WGUE = WS_WDD + 7 * MiB;
constexpr size_t WS_WDE = WS_WGUE + 56 * MiB;
constexpr size_t WS_XB = WS_WDE + 28 * MiB;
constexpr size_t WS_DC = WS_XB + 64 * MiB;
constexpr size_t WS_DN = WS_DC + 10752 * 1024;
constexpr size_t WS_ACT0 = 215 * MiB;
static_assert(WS_DN + 172032 <= WS_ACT0, "weights");
constexpr size_t WS_HB = WS_ACT0;
constexpr size_t WS_CQN = WS_HB;
constexpr size_t WS_CKVN = WS_HB + 16 * MiB;
constexpr size_t WS_P1 = WS_HB + 64 * MiB;
constexpr size_t WS_P2 = WS_P1 + 64 * MiB;
constexpr size_t WS_VTC = WS_P2;
constexpr size_t WS_Y = WS_P1;
constexpr size_t WS_VTAB = WS_P2 + 64 * MiB;
constexpr size_t WS_QBC = WS_VTAB + 40 * MiB;
constexpr size_t WS_KBC = WS_QBC + 24 * MiB;
constexpr size_t WS_QC = WS_KBC + 24 * MiB;
constexpr size_t WS_KC = WS_QC + 36 * MiB;
constexpr size_t WS_END = WS_KC + 36 * MiB;
constexpr size_t WS_ACT = WS_P1;
#ifndef DENSE_FP8
#define DENSE_FP8 2
#endif
constexpr size_t WS_Y2 = WS_ACT + (DENSE_FP8 == 1 ? 112 : 224) * MiB;
constexpr size_t WS_YM = WS_ACT + 112 * MiB;
constexpr size_t WS_H8 = WS_YM + 128 * MiB;
static_assert(WS_Y2 + 64 * MiB <= WS_END && WS_H8 + 32 * MiB <= WS_END && (DENSE_FP8 != 1 || WS_Y2 + 64 * MiB <= WS_H8), "ffn overlay");
static_assert(WS_END <= 594600000ull, "workspace");
constexpr int CW_BAR = 4096;
constexpr int CW_ATTQ = 64;
constexpr int CW_MOECNT = 256;
constexpr int MOE_CHUNK_TILES = 128, MOE_MAX_CHUNKS = 3;

constexpr int RING_BYTES = 131072;
constexpr int MISC_OFF = RING_BYTES;
constexpr int LDS_BYTES = 147456;

DI unsigned cvtpk(float lo, float hi) { f32x2 v = {lo, hi}; bf16x2_t b = __builtin_convertvector(v, bf16x2_t); return __builtin_bit_cast(unsigned, b); }
DI unsigned pk4_fp8(float a, float b, float c, float d) { int p = __builtin_amdgcn_cvt_pk_fp8_f32(a, b, 0, false); p = __builtin_amdgcn_cvt_pk_fp8_f32(c, d, p, true); return (unsigned)p; }
DI float bf2f(unsigned short b) { return __builtin_bit_cast(float, (unsigned)b << 16); }
DI float bflo(unsigned w) { return __builtin_bit_cast(float, w << 16); }
DI float bfhi(unsigned w) { return __builtin_bit_cast(float, w & 0xffff0000u); }
DI float lane_read(float v, int src_lane) { return __builtin_bit_cast(float, __builtin_amdgcn_ds_bpermute(src_lane << 2, __builtin_bit_cast(int, v))); }
template <int CTRL, int RM> DI float dpp_mov_(float v) { return __builtin_bit_cast(float, __builtin_amdgcn_update_dpp(0, __builtin_bit_cast(int, v), CTRL, RM, 0xf, false)); }
#define DPP_SUM_STEPS(v) do { v += dpp_mov_<0xB1, 0xf>(v); v += dpp_mov_<0x4E, 0xf>(v); v += dpp_mov_<0x141, 0xf>(v); v += dpp_mov_<0x140, 0xf>(v);   \
        v += dpp_mov_<0x142, 0xa>(v); v += dpp_mov_<0x143, 0xc>(v); } while (0)
DI float wave_sum(float v, int lane) { (void)lane; DPP_SUM_STEPS(v); return __builtin_bit_cast(float, __builtin_amdgcn_readlane(__builtin_bit_cast(int, v), 63)); }
DI void wave_sum2(float& a, float& b, int lane) { (void)lane; DPP_SUM_STEPS(a); DPP_SUM_STEPS(b);
    a = __builtin_bit_cast(float, __builtin_amdgcn_readlane(__builtin_bit_cast(int, a), 63)); b = __builtin_bit_cast(float, __builtin_amdgcn_readlane(__builtin_bit_cast(int, b), 63)); }
DI float half_swap_sum(float v) { auto rr = __builtin_amdgcn_permlane32_swap(__float_as_uint(v), __float_as_uint(v), false, false); return __uint_as_float(rr[0]) + __uint_as_float(rr[1]); }
DI float half_swap_max(float v) { auto rr = __builtin_amdgcn_permlane32_swap(__float_as_uint(v), __float_as_uint(v), false, false); return fmaxf(__uint_as_float(rr[0]), __uint_as_float(rr[1])); }
DI float siluf(float x) { return x * __builtin_amdgcn_rcpf(1.f + __builtin_amdgcn_exp2f(x * -1.4426950408889634f)); }
DI float sigmoidf_(float x) { return __builtin_amdgcn_rcpf(1.f + __builtin_amdgcn_exp2f(x * -1.4426950408889634f)); }
#define LDS_WAIT() asm volatile("s_waitcnt lgkmcnt(0)" ::: "memory")
#define VM_WAIT() asm volatile("s_waitcnt vmcnt(0)" ::: "memory")

#define XB_TMO      128
#define XB_XCNT(j)  (256  + 64 * (j))
#define XB_XSUB(j)  (1280 + 64 * (j))
#define XB_XGEN(j)  (2304 + 64 * (j))
#define XB_TOP      3328
#define XB_TOPGEN   3392
#define XCD_BAR_WORDS 3456
#define XB_SPIN_CAP (1u << 22)
DI unsigned xb_ld(unsigned* p)              { return __hip_atomic_load(p, __ATOMIC_RELAXED, __HIP_MEMORY_SCOPE_AGENT); }
DI unsigned xb_add(unsigned* p, unsigned v) { return __hip_atomic_fetch_add(p, v, __ATOMIC_RELAXED, __HIP_MEMORY_SCOPE_AGENT); }
DI unsigned xb_xcc_id() { return (unsigned)__builtin_amdgcn_s_getreg((3 << 11) | 20) & 0xFu; }
#define XB_SPIN(cond, bar) do { unsigned _sp = 0; while (cond) { __builtin_amdgcn_s_sleep(1); \
    if ((++_sp & 255u) == 0u) { if (xb_ld(&(bar)[XB_TMO])) break; if (_sp > XB_SPIN_CAP) { atomicAdd(&(bar)[XB_TMO], 1u); break; } } } } while (0)
struct XcdBarrier { unsigned* bar; unsigned x; volatile LAS unsigned* st; };
DI XcdBarrier xcd_barrier_post(unsigned* bar, volatile LAS unsigned* st, bool leader) {
    XcdBarrier b; b.bar = bar; b.x = xb_xcc_id(); b.st = st;
    if (leader) (void)xb_add(&bar[XB_XCNT(b.x)], 1u);
    return b;
}
DI void xcd_barrier_complete(unsigned* bar, unsigned x, unsigned& nloc, unsigned& nx) {
    const unsigned G = gridDim.x * gridDim.y * gridDim.z;
    unsigned sum, cnt, mine, sp = 0u;
    for (;;) {
        sum = 0u; cnt = 0u; mine = 0u;
#pragma unroll
        for (unsigned j = 0; j < 16; ++j) { const unsigned c = xb_ld(&bar[XB_XCNT(j)]); sum += c; cnt += (c > 0u) ? 1u : 0u; mine = (j == x) ? c : mine; }
        if (sum == G) break;
        __builtin_amdgcn_s_sleep(1);
        if ((++sp & 255u) == 0u) { if (xb_ld(&bar[XB_TMO])) break; if (sp > XB_SPIN_CAP) { atomicAdd(&bar[XB_TMO], 1u); break; } }
    }
    nloc = mine > 0u ? mine : 1u; nx = cnt > 0u ? cnt : 1u;
}
DI void xcd_barrier(const XcdBarrier& b, int wave_id) {
    int ln_; asm volatile("v_mbcnt_lo_u32_b32 %0, -1, 0\n\tv_mbcnt_hi_u32_b32 %0, -1, %0" : "=v"(ln_)); const bool leader = (wave_id == 0) && (ln_ == 0);
    asm volatile("s_waitcnt vmcnt(0)" ::: "memory");
    __syncthreads();
    if (leader) {
        unsigned* bar = b.bar;
        __builtin_amdgcn_s_waitcnt(0);
        unsigned nloc = b.st[0], nx = b.st[1];
        if (nloc == 0u) { xcd_barrier_complete(bar, b.x, nloc, nx); b.st[0] = nloc; b.st[1] = nx; }
        const unsigned old = xb_add(&bar[XB_XSUB(b.x)], 1u);
        const unsigned gen = old / nloc;
        if (old + 1u == (gen + 1u) * nloc) {
            __builtin_amdgcn_fence(__ATOMIC_RELEASE, "agent");
            asm volatile("s_waitcnt vmcnt(0)" ::: "memory");
            const unsigned og = xb_add(&bar[XB_TOP], 1u);
            const unsigned tg = og / nx;
            if (og + 1u == (tg + 1u) * nx) xb_add(&bar[XB_TOPGEN], 1u);
            else XB_SPIN(xb_ld(&bar[XB_TOPGEN]) == tg, bar);
            __builtin_amdgcn_fence(__ATOMIC_ACQUIRE, "agent");
            xb_add(&bar[XB_XGEN(b.x)], 1u);
            asm volatile("s_waitcnt vmcnt(0)" ::: "memory");
        } else {
            XB_SPIN(xb_ld(&bar[XB_XGEN(b.x)]) == gen, bar);
            __builtin_amdgcn_fence(__ATOMIC_ACQUIRE, "agent");
            asm volatile("s_waitcnt vmcnt(0)" ::: "memory");
        }
    }
    __syncthreads();
}

namespace pg8 {
constexpr int BM = 256, BK = 64, HALF = 128, HTB = HALF * BK * 2, STAGE_BYTES = 8 * HTB, NXCD = 8, WGM = 8;
__host__ __device__ __forceinline__ int lds_byte(int r, int c) { const int st = (r >> 4) * 2 + (c >> 5), rr = r & 15, cc = c & 31, ob = rr * 64 + cc * 2; return st * 1024 + (ob ^ (((ob >> 9) & 1) << 5)); }
__host__ __device__ __forceinline__ void stage_rc(int b, int& R, int& C) { const int st = b / 1024, sb = b % 1024, swz = sb ^ (((sb >> 9) & 1) << 5); R = (st >> 1) * 16 + swz / 64; C = (st & 1) * 32 + (swz % 64) / 2; }
__host__ __device__ __forceinline__ int perm32(int rho) { const int n = rho >> 4, i = rho & 15; return 8 * (i >> 2) + 4 * n + (i & 3); }

struct Unit { int pm, pn; int arow; int brow; int lidx; int nvalid; };
enum { EPI_STORE = 0, EPI_ROPEQ = 1, EPI_KNOPE = 2, EPI_SWIGLU = 3, EPI_SCATTER = 4, EPI_SWIGLU8 = 5 };
enum { SCH_STATIC = 0, SCH_MOE = 1 };
struct Job {
    const bf16* A; const bf16* Bt; int lda, ldb, K;
    int nM, nN;
    int sched, rot;
    int epi;
    bf16* O; int ldc; int row_limit; int split_cols; long split_stride;
    const float* cs;
    const int* glist;
    int gather;
    int tile0;
    int bexp_rows;
};
struct MoeMeta { int pref[9]; int cnt[8]; };

template <bool MOE> DI bool sched_next(const Job& J, const LAS int* mm  , int i, int G, int c, Unit& u) {
    const int nwg = J.nM * J.nN;
    const long L = (long)i * G + ((c + J.rot) % G); if (L >= nwg) return false;
    int wgid = (int)L; { const int q = nwg / NXCD, r = nwg % NXCD, xcd = wgid % NXCD, off = wgid / NXCD; wgid = (xcd < r ? xcd * (q + 1) : r * (q + 1) + (xcd - r) * q) + off; }
    const int nig = WGM * J.nN, gid = wgid / nig, fm = gid * WGM, gsz = (J.nM - fm) < WGM ? (J.nM - fm) : WGM;
    u.pm = fm + ((wgid % nig) % gsz); u.pn = (wgid % nig) / gsz;
    u.arow = u.pm * BM; u.brow = u.pn * BM; u.lidx = 0; u.nvalid = BM;
    if constexpr (MOE) {
        const int tg = J.tile0 + u.pm; int e = 0;
#pragma unroll
        for (int k = 1; k < 8; ++k) e += (tg >= mm[k]) ? 1 : 0;
        const int t = tg - mm[e];
        u.lidx = e * 32768 + t * 256; const int rem = mm[9 + e] - t * 256; u.nvalid = rem < 256 ? rem : 256;
        u.brow = e * J.bexp_rows + u.pn * BM;
    }
    return true;
}

template <int EPI> DI void epilogue(const Job& J, const f32x4 (&acc)[2][2][4][2], const Unit& u, int wr, int wc, int fr_, int fq_) {
    int ln_; asm volatile("v_mbcnt_lo_u32_b32 %0, -1, 0\n\tv_mbcnt_hi_u32_b32 %0, -1, %0" : "=v"(ln_));
    const int fr = ln_ & 15, fq = ln_ >> 4; (void)fr_; (void)fq_;
    const int rloc0 = wr * 64 + fr;
    const int cloc0 = wc * 32 + 8 * fq;
    if constexpr (EPI == EPI_STORE) {
        int colt = u.pn * BM; bf16* base = J.O;
        if (J.split_cols) { const int t = colt / J.split_cols; base += (long)t * J.split_stride; colt -= t * J.split_cols; }
#pragma unroll
        for (int ai = 0; ai < 2; ++ai)
#pragma unroll
            for (int m = 0; m < 4; ++m) { const int row = u.pm * BM + rloc0 + ai * HALF + m * 16;
                if (row < J.row_limit) { bf16* rowp = base + (size_t)row * J.ldc + colt + cloc0;
#pragma unroll
                    for (int bj = 0; bj < 2; ++bj) { const f32x4 v0 = acc[ai][bj][m][0], v1 = acc[ai][bj][m][1]; u32x4 w; w.x = cvtpk(v0[0], v0[1]); w.y = cvtpk(v0[2], v0[3]); w.z = cvtpk(v1[0], v1[1]); w.w = cvtpk(v1[2], v1[3]);
                        *(u32x4*)(rowp + bj * HALF) = w; } } }
    } else if constexpr (EPI == EPI_ROPEQ) {
#pragma unroll
        for (int bj = 0; bj < 2; ++bj) { const int col = u.pn * BM + bj * HALF + cloc0;
            if (col < 576) { const int d = col % 96; const bool rp = d >= 64; const int g4 = rp ? (d - 64) >> 1 : 0;
                f32x4 csv[2][4], snv[2][4];
#pragma unroll
                for (int ai = 0; ai < 2; ++ai)
#pragma unroll
                    for (int m = 0; m < 4; ++m) { const int row = u.pm * BM + rloc0 + ai * HALF + m * 16; csv[ai][m] = *(const f32x4*)(J.cs + (size_t)row * 32 + g4); snv[ai][m] = *(const f32x4*)(J.cs + (size_t)row * 32 + 16 + g4); }
#pragma unroll
                for (int ai = 0; ai < 2; ++ai)
#pragma unroll
                    for (int m = 0; m < 4; ++m) { const int row = u.pm * BM + rloc0 + ai * HALF + m * 16; f32x4 v0 = acc[ai][bj][m][0], v1 = acc[ai][bj][m][1];
                        if (rp) { const f32x4 cs = csv[ai][m], sn = snv[ai][m];
                            const f32x4 o1 = v0 * cs - v1 * sn, o2 = v0 * sn + v1 * cs; v0 = o1; v1 = o2; }
                        v0 *= MLA_QSCALE; v1 *= MLA_QSCALE;
                        u32x4 w; w.x = cvtpk(v0[0], v0[1]); w.y = cvtpk(v0[2], v0[3]); w.z = cvtpk(v1[0], v1[1]); w.w = cvtpk(v1[2], v1[3]);
                        *(u32x4*)(J.O + (size_t)row * 576 + col) = w; } } }
    } else if constexpr (EPI == EPI_KNOPE) {
#pragma unroll
        for (int bj = 0; bj < 2; ++bj) { const int col = u.pn * BM + bj * HALF + cloc0;
            if (col < 384) { const int oc = (col >> 6) * 96 + (col & 63);
#pragma unroll
                for (int ai = 0; ai < 2; ++ai)
#pragma unroll
                    for (int m = 0; m < 4; ++m) { const int row = u.pm * BM + rloc0 + ai * HALF + m * 16; const f32x4 v0 = acc[ai][bj][m][0], v1 = acc[ai][bj][m][1];
                        u32x4 w; w.x = cvtpk(v0[0], v0[1]); w.y = cvtpk(v0[2], v0[3]); w.z = cvtpk(v1[0], v1[1]); w.w = cvtpk(v1[2], v1[3]);
                        *(u32x4*)(J.O + (size_t)row * 576 + oc) = w; } } }
    } else if constexpr (EPI == EPI_SWIGLU) {
#pragma unroll
        for (int ai = 0; ai < 2; ++ai)
#pragma unroll
            for (int m = 0; m < 4; ++m) { const int row = u.pm * BM + rloc0 + ai * HALF + m * 16; u32x4 w; float o[8];
#pragma unroll
                for (int n = 0; n < 2; ++n)
#pragma unroll
                    for (int q = 0; q < 4; q += 2) {
                        const f32x2 g2 = {acc[ai][0][m][n][q], acc[ai][0][m][n][q + 1]}, u2 = {acc[ai][1][m][n][q], acc[ai][1][m][n][q + 1]};
                        f32x2 d2 = {__builtin_amdgcn_exp2f(g2.x), __builtin_amdgcn_exp2f(g2.y)}; d2 += (f32x2){1.f, 1.f};
                        const f32x2 r2 = {__builtin_amdgcn_rcpf(d2.x), __builtin_amdgcn_rcpf(d2.y)}, o2 = (g2 * u2) * r2; o[n * 4 + q] = o2.x; o[n * 4 + q + 1] = o2.y; }
                w.x = cvtpk(o[0], o[1]); w.y = cvtpk(o[2], o[3]); w.z = cvtpk(o[4], o[5]); w.w = cvtpk(o[6], o[7]);
                *(u32x4*)(J.O + (size_t)row * J.ldc + u.pn * HALF + cloc0) = w; }
    } else if constexpr (EPI == EPI_SWIGLU8) {
#pragma unroll
        for (int ai = 0; ai < 2; ++ai)
#pragma unroll
            for (int m = 0; m < 4; ++m) { const int row = u.pm * BM + rloc0 + ai * HALF + m * 16; float o[8];
#pragma unroll
                for (int n = 0; n < 2; ++n)
#pragma unroll
                    for (int q = 0; q < 4; q += 2) {
                        const f32x2 g2 = {acc[ai][0][m][n][q], acc[ai][0][m][n][q + 1]}, u2 = {acc[ai][1][m][n][q], acc[ai][1][m][n][q + 1]};
                        f32x2 d2 = {__builtin_amdgcn_exp2f(g2.x), __builtin_amdgcn_exp2f(g2.y)}; d2 += (f32x2){1.f, 1.f};
                        const f32x2 r2 = {__builtin_amdgcn_rcpf(d2.x), __builtin_amdgcn_rcpf(d2.y)}, o2 = (g2 * u2) * r2; o[n * 4 + q] = o2.x; o[n * 4 + q + 1] = o2.y; }
                u32x2 w; w.x = pk4_fp8(o[0], o[1], o[2], o[3]); w.y = pk4_fp8(o[4], o[5], o[6], o[7]);
                *(u32x2*)((unsigned char*)J.O + (size_t)row * J.ldc + u.pn * HALF + cloc0) = w; }
    } else {
        int slots[2][4];
#pragma unroll
        for (int ai = 0; ai < 2; ++ai)
#pragma unroll
            for (int m = 0; m < 4; ++m) { const int rl = rloc0 + ai * HALF + m * 16; slots[ai][m] = J.glist[u.lidx + (rl < u.nvalid ? rl : u.nvalid - 1)]; }
#pragma unroll
        for (int ai = 0; ai < 2; ++ai)
#pragma unroll
            for (int m = 0; m < 4; ++m) { const int rl = rloc0 + ai * HALF + m * 16;
                bf16* rowp = (rl < u.nvalid) ? J.O + (size_t)slots[ai][m] * J.ldc + u.pn * BM + cloc0 : (bf16*)J.cs + cloc0;
#pragma unroll
                for (int bj = 0; bj < 2; ++bj) { const f32x4 v0 = acc[ai][bj][m][0], v1 = acc[ai][bj][m][1]; u32x4 w; w.x = cvtpk(v0[0], v0[1]); w.y = cvtpk(v0[2], v0[3]); w.z = cvtpk(v1[0], v1[1]); w.w = cvtpk(v1[2], v1[3]);
                    *(u32x4*)(rowp + bj * HALF) = w; } }
    }
}

template <int EPI, bool MOE, bool FP8 = false> DI void gemm_phase(LAS unsigned char* lds, const LAS int* mm, const Job& J, int G, int cu, int wave_id) {
    constexpr bool GATHER = MOE && (EPI == EPI_SWIGLU || EPI == EPI_SWIGLU8);
    constexpr int ESZ = FP8 ? 1 : 2;
    int tid; asm volatile("v_mbcnt_lo_u32_b32 %0, -1, 0\n\tv_mbcnt_hi_u32_b32 %0, -1, %0" : "=v"(tid)); tid += wave_id * 64;
    const int wid = __builtin_amdgcn_readfirstlane(tid >> 6), lane = tid & 63, wr = wid >> 2, wc = wid & 3, fr = lane & 15, fq = lane >> 4;
    const int K = J.K, nt = K * ESZ / 128;
    unsigned voffB[2];
#pragma unroll
    for (int i = 0; i < 2; ++i) { int R, C; stage_rc(tid * 16 + i * 8192, R, C); const int Rb = (R & ~31) + perm32(R & 31); voffB[i] = (unsigned)(Rb * J.ldb * ESZ + C * 2); }
    const size_t kstep = (size_t)(BK * 2);
    const size_t hstepB = (size_t)HALF * J.ldb * ESZ;
    const unsigned ldsw = (unsigned)wid * 1024u;
    const int aoff = lds_byte(wr * 64 + fr, fq * (FP8 ? 16 : 8)), boff = lds_byte(wc * 32 + fr, fq * (FP8 ? 16 : 8));
    constexpr int KOFF = FP8 ? 16 : 1024;
#define PG8_SA(b, h) (((b) * 2 + (h)) * HTB)
#define PG8_SB(b, h) ((4 + (b) * 2 + (h)) * HTB)
#define PG8_STAGE_B(bufoff, gbase) do { _Pragma("unroll") for (int _i = 0; _i < 2; ++_i) \
        __builtin_amdgcn_global_load_lds((const unsigned*)((const char*)(gbase) + voffB[_i]), (LAS unsigned*)(lds + (bufoff) + ldsw + _i * 8192), 16, 0, 0); } while (0)
#define PG8_STAGE_A(bufoff, kbyte, O0, O1) do { \
        __builtin_amdgcn_global_load_lds((const unsigned*)((const char*)J.A + (kbyte) + (O0)), (LAS unsigned*)(lds + (bufoff) + ldsw), 16, 0, 0); \
        __builtin_amdgcn_global_load_lds((const unsigned*)((const char*)J.A + (kbyte) + (O1)), (LAS unsigned*)(lds + (bufoff) + ldsw + 8192), 16, 0, 0); } while (0)
#define PG8_LD8(dst, addr) do { const u32x4 lo_ = *(const LAS u32x4*)(addr), hi_ = *(const LAS u32x4*)((addr) + KOFF); \
        dst = (i32x8){(int)lo_.x, (int)lo_.y, (int)lo_.z, (int)lo_.w, (int)hi_.x, (int)hi_.y, (int)hi_.z, (int)hi_.w}; } while (0)
#define PG8_LDA(dst, b, h) do { _Pragma("unroll") for (int m = 0; m < 4; ++m) PG8_LD8(dst[m], lds + PG8_SA(b, h) + aoff + m * 2048); } while (0)
#define PG8_LDB(dst, b, h) do { _Pragma("unroll") for (int n = 0; n < 2; ++n) PG8_LD8(dst[n], lds + PG8_SB(b, h) + boff + n * 2048); } while (0)
#define PG8_LO(v) __builtin_bit_cast(bf16x8, __builtin_shufflevector(v, v, 0, 1, 2, 3))
#define PG8_HI(v) __builtin_bit_cast(bf16x8, __builtin_shufflevector(v, v, 4, 5, 6, 7))
#define PG8_MMA(ai, bj, At, Bt) do { __builtin_amdgcn_s_setprio(1); _Pragma("unroll") for (int m = 0; m < 4; ++m) _Pragma("unroll") for (int n = 0; n < 2; ++n) { \
        if constexpr (FP8) asm volatile("v_mfma_scale_f32_16x16x128_f8f6f4 %0, %1, %2, %0, %3, %4 op_sel_hi:[0,0,0]" : "+v"(acc[ai][bj][m][n]) : "v"(Bt[n]), "v"(At[m]), "v"(scw), "v"(scw));   \
        else { acc[ai][bj][m][n] = __builtin_amdgcn_mfma_f32_16x16x32_bf16(PG8_LO(Bt[n]), PG8_LO(At[m]), acc[ai][bj][m][n], 0, 0, 0); \
               acc[ai][bj][m][n] = __builtin_amdgcn_mfma_f32_16x16x32_bf16(PG8_HI(Bt[n]), PG8_HI(At[m]), acc[ai][bj][m][n], 0, 0, 0); } } \
        __builtin_amdgcn_s_setprio(0); } while (0)
#define PG8_WAIT_V(n) asm volatile("s_waitcnt vmcnt(" #n ")" ::: "memory")
#define PG8_WAIT_L(n) asm volatile("s_waitcnt lgkmcnt(" #n ")" ::: "memory")
#define PG8_BAR __builtin_amdgcn_s_barrier()
#define PG8_SCHED __builtin_amdgcn_sched_barrier(0)
#define PG8_AOFF(o, U) do { _Pragma("unroll") for (int _h = 0; _h < 2; ++_h) _Pragma("unroll") for (int _i = 0; _i < 2; ++_i) { int _R, _C; stage_rc(tid * 16 + _i * 8192, _R, _C); const int _r = _h * HALF + _R; int _row; \
        if constexpr (GATHER) { _row = J.glist[(U).lidx + (_r < (U).nvalid ? _r : (U).nvalid - 1)] >> 1; } else _row = (U).arow + _r; \
        o[_h * 2 + _i] = (unsigned)(_row * J.lda * ESZ + _C * 2); } } while (0)
    Unit cur, nxt; int ui = 0;
    if (!sched_next<MOE>(J, mm, 0, G, cu, cur)) return;
    f32x4 acc[2][2][4][2];
#pragma unroll
    for (int a = 0; a < 2; ++a)
#pragma unroll
        for (int b = 0; b < 2; ++b)
#pragma unroll
            for (int m = 0; m < 4; ++m)
#pragma unroll
                for (int n = 0; n < 2; ++n) acc[a][b][m][n] = (f32x4){0.f, 0.f, 0.f, 0.f};
    i32x8 At[4], B0[2], B1[2];
    const int scw = 0x7c7c7c7c;
    unsigned oA[4];
    PG8_AOFF(oA, cur);
    const char* cB = (const char*)J.Bt + (size_t)cur.brow * J.ldb * ESZ;
    PG8_STAGE_B(PG8_SB(0, 0), cB); PG8_STAGE_B(PG8_SB(0, 1), cB + hstepB); PG8_STAGE_A(PG8_SA(0, 0), 0, oA[0], oA[1]); PG8_STAGE_A(PG8_SA(0, 1), 0, oA[2], oA[3]);
    if (wr == 1) PG8_BAR;
    PG8_WAIT_V(2); PG8_BAR;
    PG8_STAGE_B(PG8_SB(1, 0), cB + kstep); PG8_STAGE_A(PG8_SA(1, 0), kstep, oA[0], oA[1]); PG8_STAGE_B(PG8_SB(1, 1), cB + hstepB + kstep);
    PG8_WAIT_V(6); PG8_BAR;
    for (;;) {
        bool has_next = false; const char* nB = cB; int graw[4];
        for (int t = 0; t < nt; t += 2) {
            const bool last = (t == nt - 2);
            if constexpr (GATHER) { if (t == nt - 4) {
                has_next = sched_next<MOE>(J, mm, ui + 1, G, cu, nxt);
                if (has_next) {
#pragma unroll
                    for (int h_ = 0; h_ < 2; ++h_)
#pragma unroll
                        for (int i_ = 0; i_ < 2; ++i_) { int R_, C_; stage_rc(tid * 16 + i_ * 8192, R_, C_); const int r_ = h_ * HALF + R_; const int* gp_ = J.glist + nxt.lidx + (r_ < nxt.nvalid ? r_ : nxt.nvalid - 1);
                            asm volatile("global_load_dword %0, %1, off" : "=v"(graw[h_ * 2 + i_]) : "v"(gp_) : "memory"); } } } }
            const size_t k1 = (size_t)(t + 1) * kstep;
            PG8_LDB(B0, 0, 0); PG8_LDB(B1, 0, 1); PG8_SCHED; PG8_LDA(At, 0, 0); PG8_STAGE_A(PG8_SA(1, 1), k1, oA[2], oA[3]);
            PG8_WAIT_V(8); PG8_WAIT_L(0); PG8_BAR; PG8_MMA(0, 0, At, B0); PG8_MMA(0, 1, At, B1); PG8_BAR; PG8_SCHED;
            if (last) {
                if constexpr (GATHER) { if (has_next) {
#pragma unroll
                        for (int q_ = 0; q_ < 4; ++q_) { int R_, C_; stage_rc(tid * 16 + (q_ & 1) * 8192, R_, C_); asm volatile("" : "+v"(graw[q_])); oA[q_] = (unsigned)((graw[q_] >> 1) * J.lda * ESZ + C_ * 2); }
                        nB = (const char*)J.Bt + (size_t)nxt.brow * J.ldb * ESZ; } }
                else { has_next = sched_next<MOE>(J, mm, ui + 1, G, cu, nxt); if (has_next) { PG8_AOFF(oA, nxt); nB = (const char*)J.Bt + (size_t)nxt.brow * J.ldb * ESZ; } } }
            const size_t k2 = last ? 0 : (size_t)(t + 2) * kstep, k3 = k2 + kstep;
            const char* b2 = last ? nB : cB + (size_t)(t + 2) * kstep; const char* b3 = b2 + kstep;
            PG8_LDA(At, 0, 1); PG8_STAGE_B(PG8_SB(0, 0), b2); PG8_STAGE_B(PG8_SB(0, 1), b2 + hstepB); PG8_STAGE_A(PG8_SA(0, 0), k2, oA[0], oA[1]);
            PG8_WAIT_V(8); PG8_WAIT_L(0); PG8_BAR; PG8_MMA(1, 0, At, B0); PG8_MMA(1, 1, At, B1); PG8_BAR; PG8_SCHED;
            PG8_LDB(B0, 1, 0); PG8_LDB(B1, 1, 1); PG8_SCHED; PG8_LDA(At, 1, 0); PG8_STAGE_A(PG8_SA(0, 1), k2, oA[2], oA[3]);
            PG8_WAIT_V(8); PG8_WAIT_L(0); PG8_BAR; PG8_MMA(0, 0, At, B0); PG8_MMA(0, 1, At, B1); PG8_BAR; PG8_SCHED;
            PG8_LDA(At, 1, 1); PG8_STAGE_B(PG8_SB(1, 0), b3); PG8_STAGE_B(PG8_SB(1, 1), b3 + hstepB); PG8_STAGE_A(PG8_SA(1, 0), k3, oA[0], oA[1]);
            PG8_WAIT_V(8); PG8_WAIT_L(0); PG8_BAR; PG8_MMA(1, 0, At, B0); PG8_MMA(1, 1, At, B1); PG8_BAR; PG8_SCHED;
        }
        if (wr == 0) PG8_BAR;
        if constexpr (FP8) {
            asm volatile("s_nop 15\n\ts_nop 15" : "+v"(acc[1][0][0][0]), "+v"(acc[1][0][0][1]), "+v"(acc[1][0][1][0]), "+v"(acc[1][0][1][1]), "+v"(acc[1][0][2][0]), "+v"(acc[1][0][2][1]), "+v"(acc[1][0][3][0]), "+v"(acc[1][0][3][1]),
                                              "+v"(acc[1][1][0][0]), "+v"(acc[1][1][0][1]), "+v"(acc[1][1][1][0]), "+v"(acc[1][1][1][1]), "+v"(acc[1][1][2][0]), "+v"(acc[1][1][2][1]), "+v"(acc[1][1][3][0]), "+v"(acc[1][1][3][1]) :: "memory"); }
        epilogue<EPI>(J, acc, cur, wr, wc, fr, fq);
        if (!has_next) break;
#pragma unroll
        for (int a = 0; a < 2; ++a)
#pragma unroll
            for (int b = 0; b < 2; ++b)
#pragma unroll
                for (int m = 0; m < 4; ++m)
#pragma unroll
                    for (int n = 0; n < 2; ++n) { f32x2 z0, z1; asm volatile("v_pk_mov_b32 %0, 0, 0\n\tv_pk_mov_b32 %1, 0, 0" : "=v"(z0), "=v"(z1)); acc[a][b][m][n] = (f32x4){z0.x, z0.y, z1.x, z1.y}; }
        cur = nxt; cB = nB; ++ui;
        if (wr == 1) PG8_BAR;
    }
    PG8_WAIT_V(0);
    PG8_BAR;
#undef PG8_SA
#undef PG8_SB
#undef PG8_STAGE_A
#undef PG8_STAGE_B
#undef PG8_LDA
#undef PG8_LD8
#undef PG8_LO
#undef PG8_HI
#undef PG8_LDB
#undef PG8_MMA
#undef PG8_WAIT_V
#undef PG8_WAIT_L
#undef PG8_BAR
#undef PG8_SCHED
#undef PG8_AOFF
}
}

struct Args { const void* in[30]; float* out; unsigned char* ws; int ph_lo, ph_hi; };
typedef const __attribute__((address_space(4))) Args* KArgs;
#define IN(i) ((const float*)a->in[i])
struct Frame {
    LAS unsigned char* lds; volatile LAS unsigned* MISC; gu32* ctl;
    int tid, lane, wave, G, cu;
    unsigned char* ws; float* out;
};
#define RELANE(F) do { int l_; asm volatile("v_mbcnt_lo_u32_b32 %0, -1, 0\n\tv_mbcnt_hi_u32_b32 %0, -1, %0" : "=v"(l_)); F.lane = l_; F.tid = F.wave * 64 + l_; } while (0)
enum { I_X = 0, I_C, I_POS, I_WADA, I_BADA, I_GNORM, I_WIN, I_WOUT, I_LQ1, I_LK1, I_LQ2, I_LK2, I_GDIFF, I_WCONV, I_BCONV, I_BIG, I_BFG, I_GML, I_GQL, I_GKVL, I_WUQ, I_WUKV,
       I_WGD, I_WUD, I_WDD, I_WR, I_BR, I_WGE, I_WUE, I_WDE };
__constant__ float ROPE_FREQ[16] = {1.0f, 0.5623413251903491f, 0.31622776601683794f, 0.1778279410038923f, 0.1f, 0.05623413251903491f, 0.031622776601683794f, 0.01778279410038923f,
                                    0.01f, 0.005623413251903491f, 0.0031622776601683794f, 0.001778279410038923f, 0.001f, 0.0005623413251903491f, 0.00031622776601683794f, 0.0001778279410038923f};

struct TrItem { const float* W; int N, k0, n0; int kind; bf16* dst; int ldd; const float* kscale; float wmul; };
DI void tr_load(const TrItem& t, int lane, f32x4 (&v)[8]) {
    const int kr = lane >> 3, nc0 = (lane & 7) * 4, nc = (t.n0 + nc0 + 4 <= t.N) ? nc0 : 0;
#pragma unroll
    for (int i = 0; i < 8; ++i) v[i] = __builtin_nontemporal_load((const GAS f32x4*)(t.W + (size_t)(t.k0 + 8 * i + kr) * t.N + t.n0 + nc));
}
DI int rope_perm(int i) { return (i < 16) ? ((i >> 2) * 8 + (i & 3)) : (((i - 16) >> 2) * 8 + 4 + ((i - 16) & 3)); }
struct MapIdent { DI int operator()(int n) const { return n; } };
struct MapWinP { DI int operator()(int n) const {
    if (n < 512) return n;
    if (n < 768) return -1;
    if (n < 1152) return 1024 + (n - 768);
    if (n < 1536) return 1024 + 384 + (n - 1152);
    if (n < 1920) return -1;
    if (n < 2304) return 512 + (n - 1920);
    if (n < 2316) return 1024 + 768 + (n - 2304);
    if (n < 2508) return 1024 + 784 + (n - 2316);
    if (n < 2636) return 896 + (n - 2508);
    return 1024 + 976 + rope_perm(n - 2636); } };
struct MapWinV { DI int operator()(int n) const { if (n >= 512 && n < 768) return n - 512; if (n >= 1536 && n < 1920) return 256 + (n - 1536); return -1; } };
struct MapUq { DI int operator()(int n) const { const int h = n / 96, d = n % 96; return h * 96 + (d < 64 ? d : 64 + rope_perm(d - 64)); } };
struct MapUkvK { DI int operator()(int n) const { const int h = n >> 7, d = n & 127; return d < 64 ? h * 64 + d : -1; } };
struct MapUkvV { DI int operator()(int n) const { const int h = n >> 7, d = n & 127; return d >= 64 ? h * 64 + d - 64 : -1; } };
struct MapGate { DI int operator()(int n) const { return (n >> 7) * 256 + (n & 127); } };
struct MapUp { DI int operator()(int n) const { return (n >> 7) * 256 + 128 + (n & 127); } };

enum { TK_WINP = 0, TK_WINV, TK_IDENT, TK_UQ, TK_UKVK, TK_UKVV, TK_GATE, TK_UP, TK_GATE8, TK_UP8, TK_IDENT8 };
DI int tr_map(int kind, int n) {
    switch (kind) { case TK_WINP: return MapWinP()(n); case TK_WINV: return MapWinV()(n); case TK_UQ: return MapUq()(n); case TK_UKVK: return MapUkvK()(n); case TK_UKVV: return MapUkvV()(n);
        case TK_GATE: case TK_GATE8: return MapGate()(n); case TK_UP: case TK_UP8: return MapUp()(n); default: return n; }
}
DI void tr_store(const TrItem& t, int lane, const f32x4 (&v)[8], LAS float* scr) {
    const int kr = lane >> 3, nc = (lane & 7) * 4;
#pragma unroll
    for (int i = 0; i < 8; ++i) { const int kk = 8 * i + kr;
#pragma unroll
        for (int q = 0; q < 4; ++q) scr[kk * 33 + nc + q] = v[i][q] * t.wmul; }
    LDS_WAIT(); asm volatile("" ::: "memory");
    const int c = lane & 7; const bool f8 = t.kind >= TK_GATE8;
#pragma unroll
    for (int j = 0; j < 4; ++j) { const int nl = (lane >> 3) + 8 * j, n = t.n0 + nl; const LAS float* s = scr + (8 * c) * 33 + nl;
        if (n < t.N) { const int drow = tr_map(t.kind, n);
            if (drow >= 0) {
                if (f8) { u32x2 o; o.x = pk4_fp8(s[0 * 33] * 64.f, s[1 * 33] * 64.f, s[2 * 33] * 64.f, s[3 * 33] * 64.f); o.y = pk4_fp8(s[4 * 33] * 64.f, s[5 * 33] * 64.f, s[6 * 33] * 64.f, s[7 * 33] * 64.f);
                    *(GAS u32x2*)((unsigned char*)t.dst + (size_t)drow * t.ldd + t.k0 + 8 * c) = o; }
                else { u32x4 o; o.x = cvtpk(s[0 * 33], s[1 * 33]); o.y = cvtpk(s[2 * 33], s[3 * 33]); o.z = cvtpk(s[4 * 33], s[5 * 33]); o.w = cvtpk(s[6 * 33], s[7 * 33]);
                    *(GAS u32x4*)(t.dst + (size_t)drow * t.ldd + t.k0 + 8 * c) = o; } } } }
    LDS_WAIT(); asm volatile("" ::: "memory");
}
DI void tr_decode(Frame& F, KArgs a, int it, TrItem& t) {
    unsigned char* ws = F.ws;
    constexpr int IT_WIN = 16 * 84, IT_WOUT = 16 * 32, IT_UQ = 3 * 18, IT_UKV = 2 * 24, IT_GU = 16 * 112, IT_DN = 56 * 32;
    constexpr int PER_LAYER = 2 * IT_WIN + IT_WOUT + IT_UQ + 2 * IT_UKV;
    constexpr int N_SMALL = DEPTH * PER_LAYER, N_DENSE = 2 * IT_GU + IT_DN;
    int r = it; t.kscale = nullptr; t.wmul = 1.f;
    auto set = [&](const float* W, int N, int nbn, int kind, bf16* dst, int ldd) { t.W = W; t.N = N; t.k0 = 64 * (r / nbn); t.n0 = 32 * (r % nbn); t.kind = kind; t.dst = dst; t.ldd = ldd; };
    if (r < N_SMALL) { const int l = r / PER_LAYER; r -= l * PER_LAYER;
        const float* win = IN(I_WIN) + (size_t)l * D * INW;
        if (r < IT_WIN) { set(win, INW, 84, TK_WINP, (bf16*)(ws + WS_WIN) + (size_t)l * 2048 * 1024, 1024); return; } r -= IT_WIN;
        if (r < IT_WIN) { set(win, INW, 84, TK_WINV, (bf16*)(ws + WS_WV) + (size_t)l * 768 * 1024, 1024); return; } r -= IT_WIN;
        if (r < IT_WOUT) { set(IN(I_WOUT) + (size_t)l * D * D, D, 32, TK_IDENT, (bf16*)(ws + WS_WOUT) + (size_t)l * D * D, D); return; } r -= IT_WOUT;
        if (r < IT_UQ) { set(IN(I_WUQ) + (size_t)l * 192 * 576, 576, 18, TK_UQ, (bf16*)(ws + WS_WUQ) + (size_t)l * 768 * 256, 256); return; } r -= IT_UQ;
        if (r < IT_UKV) { set(IN(I_WUKV) + (size_t)l * 128 * 768, 768, 24, TK_UKVK, (bf16*)(ws + WS_WUKK) + (size_t)l * 512 * 128, 128); return; } r -= IT_UKV;
        set(IN(I_WUKV) + (size_t)l * 128 * 768, 768, 24, TK_UKVV, (bf16*)(ws + WS_WUKV) + (size_t)l * 512 * 128, 128); return; }
    r -= N_SMALL;
    const float *wg, *wu, *wd; bf16 *gu, *dn; bool f8 = DENSE_FP8 != 0, f8d = DENSE_FP8 == 1;
    if (r < N_DENSE) { wg = IN(I_WGD); wu = IN(I_WUD); wd = IN(I_WDD); gu = (bf16*)(ws + WS_WGUD); dn = (bf16*)(ws + WS_WDD); }
    else { r -= N_DENSE; const int e = r / (2 * IT_GU + IT_DN); r -= e * (2 * IT_GU + IT_DN); f8 = true;
        wg = IN(I_WGE) + (size_t)e * D * DFF; wu = IN(I_WUE) + (size_t)e * D * DFF; wd = IN(I_WDE) + (size_t)e * DFF * D; f8d = true;
        gu = (bf16*)(ws + WS_WGUE + (size_t)e * 7168 * 1024); dn = (bf16*)(ws + WS_WDE + (size_t)e * 1024 * 3584); }
    if (r < IT_GU) { set(wg, DFF, 112, f8 ? TK_GATE8 : TK_GATE, gu, 1024); t.wmul = -1.4426950408889634f; return; } r -= IT_GU;
    if (r < IT_GU) { set(wu, DFF, 112, f8 ? TK_UP8 : TK_UP, gu, 1024); t.wmul = -0.6931471805599453f; return; } r -= IT_GU;
    set(wd, D, 32, f8d ? TK_IDENT8 : TK_IDENT, dn, 3584);
}
constexpr int TR_N_SMALL = DEPTH * (2 * 16 * 84 + 16 * 32 + 3 * 18 + 2 * 2 * 24);
constexpr int TR_N_EARLY = TR_N_SMALL + (2 * 16 * 112 + 56 * 32);
constexpr int TR_N_MOE = NEXP * (2 * 16 * 112 + 56 * 32), TR_MOE_CHUNK = 84, TR_MOE_CHUNKS = TR_N_MOE / TR_MOE_CHUNK;
static_assert(TR_MOE_CHUNKS * TR_MOE_CHUNK == TR_N_MOE && TR_MOE_CHUNKS * 4 == 2048, "expert weight items split evenly; one chunk per four mixer units");
DI void tr_run(Frame& F, KArgs a, int first, int end, int stride, LAS float* scr) {
    TrItem tA, tB, tC; f32x4 vA[8], vB[8], vC[8];
    int lane = F.lane; asm volatile("" : "+v"(lane));
    if (first >= end) return;
    const int lastit = first + ((end - 1 - first) / stride) * stride;
    int it = first;
#define TR_CL(x) ((x) <= lastit ? (x) : lastit)
    tr_decode(F, a, it, tA); tr_load(tA, lane, vA);
    tr_decode(F, a, TR_CL(it + stride), tB); tr_load(tB, lane, vB);
    for (;;) {
        tr_decode(F, a, TR_CL(it + 2 * stride), tC); tr_load(tC, lane, vC);
        tr_store(tA, lane, vA, scr); it += stride; if (it > lastit) break;
        tr_decode(F, a, TR_CL(it + 2 * stride), tA); tr_load(tA, lane, vA);
        tr_store(tB, lane, vB, scr); it += stride; if (it > lastit) break;
        tr_decode(F, a, TR_CL(it + 2 * stride), tB); tr_load(tB, lane, vB);
        tr_store(tC, lane, vC, scr); it += stride; if (it > lastit) break;
    }
#undef TR_CL
}
DI void p0_prologue(Frame& F, KArgs a) {
    LAS float* scr = (LAS float*)(F.lds + F.wave * 16384);
    const int gw = F.cu * NWAVES + F.wave, NGW = F.G * NWAVES;
    unsigned char* ws = F.ws;
    tr_run(F, a, gw, (F.G == 256) ? TR_N_SMALL : TR_N_EARLY, NGW, scr);
    { unsigned z = 0u; asm volatile("" : "+v"(z));
      for (int i = gw * 64 + F.lane; i < DEPTH * 768 * 8; i += NGW * 64) { const int row = i >> 3, c = i & 7; *(GAS u32x4*)((bf16*)(ws + WS_WUQ) + (size_t)row * 256 + 192 + c * 8) = (u32x4){z, z, z, z}; } }
    { const int* pos = (const int*)IN(I_POS); float* cs = (float*)(ws + WS_CS);
      for (int i = gw * 64 + F.lane; i < NTOK * 16; i += NGW * 64) { const int row = i >> 4, k = i & 15; const float ang = (float)pos[row] * ROPE_FREQ[k];
          double t = (double)ang * 0.15915494309189535; t -= __builtin_floor(t); const float tf = (float)t;
          cs[(size_t)row * 32 + k] = __builtin_amdgcn_cosf(tf); cs[(size_t)row * 32 + 16 + k] = __builtin_amdgcn_sinf(tf); } }
    __syncthreads();
    { LAS float* sc = (LAS float*)F.lds;
      LAS float* red = (LAS float*)(F.lds + 65536);
      const float* c = IN(I_C);
      for (int i = F.tid; i < 16 * 1024; i += NTHR) sc[(i & 1023) * 16 + (i >> 10)] = siluf(c[i]);
      __syncthreads();
      float* mod = (float*)(ws + WS_MOD);
      for (int item = F.cu; item < 4 * 48; item += F.G) { const int lj = item / 48, n0 = (item % 48) * 64;
          const float* w = IN(I_WADA) + (size_t)lj * D * 3072 + n0 + F.lane; float accv[16];
#pragma unroll
          for (int b = 0; b < 16; ++b) accv[b] = 0.f;
          const int kbeg = F.wave * 128;
          for (int k0 = kbeg; k0 < kbeg + 128; k0 += 32) { float wv[32];
#pragma unroll
              for (int i = 0; i < 32; ++i) wv[i] = w[(size_t)(k0 + i) * 3072];
#pragma unroll
              for (int i = 0; i < 32; ++i) { const LAS f32x4* sp = (const LAS f32x4*)(sc + (k0 + i) * 16); const f32x4 s0 = sp[0], s1 = sp[1], s2 = sp[2], s3 = sp[3]; const float x = wv[i];
                  accv[0] += s0.x * x; accv[1] += s0.y * x; accv[2] += s0.z * x; accv[3] += s0.w * x; accv[4] += s1.x * x; accv[5] += s1.y * x; accv[6] += s1.z * x; accv[7] += s1.w * x;
                  accv[8] += s2.x * x; accv[9] += s2.y * x; accv[10] += s2.z * x; accv[11] += s2.w * x; accv[12] += s3.x * x; accv[13] += s3.y * x; accv[14] += s3.z * x; accv[15] += s3.w * x;
                  if ((i & 3) == 3) __builtin_amdgcn_sched_barrier(0); } }
#pragma unroll
          for (int b = 0; b < 16; ++b) red[(F.wave * 16 + b) * 64 + F.lane] = accv[b];
          __syncthreads();
          for (int o = F.tid; o < 16 * 64; o += NTHR) { const int b = o >> 6, n = o & 63; float s = 0.f;
#pragma unroll
              for (int wv = 0; wv < 8; ++wv) s += red[(wv * 16 + b) * 64 + n];
              mod[((size_t)lj * 16 + b) * 3072 + n0 + n] = s + IN(I_BADA)[(size_t)lj * 3072 + n0 + n]; }
          __syncthreads(); } }
}

DI void row_load_f32(const float* p, int lane, f32x4 (&v)[4]) { const GAS f32x4* q = (const GAS f32x4*)p + lane;
#pragma unroll
    for (int j = 0; j < 4; ++j) v[j] = q[64 * j]; }
DI void row_load_bf16(const bf16* p, int lane, f32x4 (&v)[4]) { const GAS u32x2* q = (const GAS u32x2*)p + lane;
#pragma unroll
    for (int j = 0; j < 4; ++j) { const u32x2 w = q[64 * j]; v[j] = (f32x4){bflo(w.x), bfhi(w.x), bflo(w.y), bfhi(w.y)}; } }
DI void raw_load_bf16(const bf16* p, int lane, u32x2 (&w)[4]) { const GAS u32x2* q = (const GAS u32x2*)p + lane;
#pragma unroll
    for (int j = 0; j < 4; ++j) w[j] = q[64 * j]; }
DI void raw_cvt_bf16(const u32x2 (&w)[4], f32x4 (&v)[4]) {
#pragma unroll
    for (int j = 0; j < 4; ++j) v[j] = (f32x4){bflo(w[j].x), bfhi(w[j].x), bflo(w[j].y), bfhi(w[j].y)}; }
DI float row_rstd(const f32x4 (&v)[4], int lane) { float s = 0.f;
#pragma unroll
    for (int j = 0; j < 4; ++j) s += (v[j].x * v[j].x + v[j].y * v[j].y) + (v[j].z * v[j].z + v[j].w * v[j].w);
    return rsqrtf(wave_sum(s, lane) * (1.f / D) + EPS); }
DI void vec_load(const float* p, int lane, f32x4 (&v)[4]) {
#pragma unroll
    for (int j = 0; j < 4; ++j) v[j] = ((const GAS f32x4*)p)[lane + 64 * j]; }
DI void mod_norm_store(const f32x4 (&x)[4], const f32x4 (&gg)[4], const f32x4 (&sh)[4], const f32x4 (&scv)[4], bf16* orow, int lane, f32x4 (&h)[4], unsigned char* o8row = nullptr) {
    const float rstd = row_rstd(x, lane);
    GAS u32x2* o8 = (GAS u32x2*)orow + lane;
#pragma unroll
    for (int j = 0; j < 4; ++j) {
        h[j] = (x[j] * rstd * gg[j]) * (scv[j] + 1.0f) + sh[j];
        if (orow) { u32x2 w; w.x = cvtpk(h[j].x, h[j].y); w.y = cvtpk(h[j].z, h[j].w); o8[64 * j] = w; }
        if (o8row) ((GAS unsigned*)o8row)[lane + 64 * j] = pk4_fp8(h[j].x, h[j].y, h[j].z, h[j].w); }
}
DI void resid_update(f32x4 (&x)[4], const f32x4 (&y)[4], const f32x4 (&gg)[4], const f32x4 (&gt)[4], int lane) {
    const float rstd = row_rstd(y, lane);
#pragma unroll
    for (int j = 0; j < 4; ++j) x[j] = x[j] + gt[j] * (y[j] * rstd * gg[j]);
}
DI void row_store_bf16(bf16* p, int lane, const f32x4 (&v)[4]) { GAS u32x2* q = (GAS u32x2*)p + lane;
#pragma unroll
    for (int j = 0; j < 4; ++j) { u32x2 w; w.x = cvtpk(v[j].x, v[j].y); w.y = cvtpk(v[j].z, v[j].w); q[64 * j] = w; } }
DI void row_store_f32(float* p, int lane, const f32x4 (&v)[4]) { GAS f32x4* q = (GAS f32x4*)p + lane;
#pragma unroll
    for (int j = 0; j < 4; ++j) q[64 * j] = v[j]; }

DI void phase_row0(Frame& F, KArgs a) {
    const float* mod = (const float*)(F.ws + WS_MOD);
    bf16* hb = (bf16*)(F.ws + WS_HB);
    const int gw = F.cu * NWAVES + F.wave, NGW = F.G * NWAVES;
    (void)gw; (void)NGW;
    for (int blk = F.cu; blk < NTOK / 128; blk += F.G) {
        const int row0 = blk * 128 + F.wave * 16; f32x4 nx[4]; row_load_f32(IN(I_X) + (size_t)row0 * D, F.lane, nx);
        f32x4 vg[4], vsh[4], vsc[4]; { const float* m_ = mod + ((size_t)0 * 16 + (row0 >> 11)) * 3072; vec_load(IN(I_GNORM), F.lane, vg); vec_load(m_, F.lane, vsh); vec_load(m_ + 1024, F.lane, vsc); }
        for (int i = 0; i < 16; ++i) { const int row = row0 + i; f32x4 x[4], h[4];
#pragma unroll
            for (int j = 0; j < 4; ++j) x[j] = nx[j];
            if (i < 15) row_load_f32(IN(I_X) + (size_t)(row + 1) * D, F.lane, nx);
            mod_norm_store(x, vg, vsh, vsc, hb + (size_t)row * D, F.lane, h); } }
}
DI void phase_row1(Frame& F, KArgs a, int l) {
    const float* modA = (const float*)(F.ws + WS_MOD) + (size_t)(l * 2 + 0) * 16 * 3072;
    const float* modB = (const float*)(F.ws + WS_MOD) + (size_t)(l * 2 + 1) * 16 * 3072;
    const float* gn = IN(I_GNORM) + (size_t)l * 4 * D;
    const bf16* y = (const bf16*)(F.ws + WS_Y); bf16* hb = (bf16*)(F.ws + WS_HB);
    bf16* xb = (bf16*)(F.ws + WS_XB);
    const bool moe = (l & 1);
    LAS float* wr_s = (LAS float*)F.lds;
    LAS int* sel = (LAS int*)(F.lds + 32768);
    LAS int* rank = (LAS int*)(F.lds + 32768 + 512);
    LAS int* base = (LAS int*)(F.lds + 32768 + 512 + 1024);
    if (moe) { for (int i = F.tid; i < 8192; i += NTHR) wr_s[i] = IN(I_WR)[i]; __syncthreads(); }
    for (int blk = F.cu; blk < NTOK / 128; blk += F.G) {
        f32x4 vg1[4], vgt[4], vg2[4], vsh[4], vsc[4]; { const int b_ = (blk * 128) >> 11; vec_load(gn + 1 * D, F.lane, vg1); vec_load(modA + (size_t)b_ * 3072 + 2048, F.lane, vgt); vec_load(gn + 2 * D, F.lane, vg2);
            vec_load(modB + (size_t)b_ * 3072, F.lane, vsh); vec_load(modB + (size_t)b_ * 3072 + 1024, F.lane, vsc); }
        f32x4 nx[4]; u32x2 nxb[4], nyb[4];
#define R1_LOAD(row_) do { if (l == 0) row_load_f32(IN(I_X) + (size_t)(row_) * D, F.lane, nx); else raw_load_bf16(xb + (size_t)(row_) * D, F.lane, nxb); raw_load_bf16(y + (size_t)(row_) * D, F.lane, nyb); } while (0)
        R1_LOAD(blk * 128 + F.wave * 16);
        for (int i = 0; i < 16; ++i) { const int rl = F.wave * 16 + i, row = blk * 128 + rl, b = row >> 11;
            f32x4 x[4], yy[4], h[4];
            if (l == 0) {
#pragma unroll
                for (int j = 0; j < 4; ++j) x[j] = nx[j]; } else raw_cvt_bf16(nxb, x);
            raw_cvt_bf16(nyb, yy);
            if (i < 15) R1_LOAD(row + 1);
            resid_update(x, yy, vg1, vgt, F.lane); (void)b;
            row_store_bf16(xb + (size_t)row * D, F.lane, x);
            const bool f8a = moe || DENSE_FP8;
            mod_norm_store(x, vg2, vsh, vsc, f8a ? nullptr : hb + (size_t)row * D, F.lane, h, f8a ? F.ws + WS_H8 + (size_t)row * D : nullptr);
            if (moe) { float lg[8];
#pragma unroll
                for (int e = 0; e < 8; ++e) lg[e] = 0.f;
#pragma unroll
                for (int j = 0; j < 4; ++j)
#pragma unroll
                    for (int q = 0; q < 4; ++q) { const int k = 4 * F.lane + 256 * j + q; const f32x4 w0 = *(const LAS f32x4*)(wr_s + k * 8), w1 = *(const LAS f32x4*)(wr_s + k * 8 + 4); const float hv = h[j][q];
                        lg[0] += hv * w0.x; lg[1] += hv * w0.y; lg[2] += hv * w0.z; lg[3] += hv * w0.w; lg[4] += hv * w1.x; lg[5] += hv * w1.y; lg[6] += hv * w1.z; lg[7] += hv * w1.w; }
#pragma unroll
                for (int e = 0; e < 8; ++e) lg[e] = wave_sum(lg[e], F.lane) + IN(I_BR)[e];
                int e0 = 0; float v0 = lg[0];
#pragma unroll
                for (int e = 1; e < 8; ++e) if (lg[e] > v0) { v0 = lg[e]; e0 = e; }
                int e1 = -1; float v1 = -INFINITY;
#pragma unroll
                for (int e = 0; e < 8; ++e) if (e != e0 && lg[e] > v1) { v1 = lg[e]; e1 = e; }
                const float p1 = __expf(v1 - v0), g0 = 1.f / (1.f + p1), g1 = p1 / (1.f + p1);
                if (F.lane == 0) { sel[rl] = e0 | (e1 << 8); float* gt = (float*)(F.ws + WS_GATE); gt[(size_t)row * 2] = g0; gt[(size_t)row * 2 + 1] = g1; } }
        }
        if (moe) { __syncthreads();
            LAS int* wcnt = rank;
            int my_e = -1, my_r = 0;
            if (F.tid < 256) { const int rl = F.tid >> 1, k = F.tid & 1; const int s = sel[rl]; my_e = k ? (s >> 8) : (s & 255);
                const unsigned long long below = (1ull << F.lane) - 1ull;
#pragma unroll
                for (int e = 0; e < 8; ++e) { const unsigned long long m = __builtin_amdgcn_ballot_w64(my_e == e); if (my_e == e) my_r = __builtin_popcountll(m & below);
                    if (F.lane == 0) wcnt[F.wave * 8 + e] = __builtin_popcountll(m); } }
            __syncthreads();
            if (F.tid < 8) { const int e = F.tid; const int n = wcnt[e] + wcnt[8 + e] + wcnt[16 + e] + wcnt[24 + e];
                base[e] = (int)__hip_atomic_fetch_add((unsigned*)(F.ctl + CW_MOECNT + e), (unsigned)n, __ATOMIC_RELAXED, __HIP_MEMORY_SCOPE_AGENT); }
            __syncthreads();
            if (F.tid < 256) { int off = base[my_e] + my_r;
                for (int w2 = 0; w2 < F.wave; ++w2) off += wcnt[w2 * 8 + my_e];
                int* list = (int*)(F.ws + WS_LIST); list[my_e * 32768 + off] = (blk * 128 + (F.tid >> 1)) * 2 + (F.tid & 1); }
            __syncthreads(); }
    }
#undef R1_LOAD
}
DI void phase_row2(Frame& F, KArgs a, int l) {
    const float* modB = (const float*)(F.ws + WS_MOD) + (size_t)(l * 2 + 1) * 16 * 3072;
    const float* gn = IN(I_GNORM) + (size_t)l * 4 * D;
    bf16* hb = (bf16*)(F.ws + WS_HB);
    const bool moe = (l & 1);
    const int gw = F.cu * NWAVES + F.wave, NGW = F.G * NWAVES;
    (void)gw; (void)NGW;
    for (int blk = F.cu; blk < NTOK / 128; blk += F.G) {
      f32x4 vg3[4], vgt[4], vgn[4], vsh[4], vsc[4]; { const int b_ = (blk * 128) >> 11; vec_load(gn + 3 * D, F.lane, vg3); vec_load(modB + (size_t)b_ * 3072 + 2048, F.lane, vgt);
          if (l + 1 < DEPTH) { const float* modN_ = (const float*)(F.ws + WS_MOD) + (size_t)((l + 1) * 2) * 16 * 3072 + (size_t)b_ * 3072; vec_load(IN(I_GNORM) + (size_t)(l + 1) * 4 * D, F.lane, vgn); vec_load(modN_, F.lane, vsh); vec_load(modN_ + 1024, F.lane, vsc); } }
      u32x2 nxb[4], nya[4], nyb[4]; float ng0 = 0.f, ng1 = 0.f;
#define R2_LOAD(row_) do { raw_load_bf16((const bf16*)(F.ws + WS_XB) + (size_t)(row_) * D, F.lane, nxb); \
        if (!moe) raw_load_bf16((const bf16*)(F.ws + WS_Y2) + (size_t)(row_) * D, F.lane, nya); \
        else { const bf16* ym_ = (const bf16*)(F.ws + WS_YM); const float* gt_ = (const float*)(F.ws + WS_GATE); raw_load_bf16(ym_ + (size_t)((row_) * 2) * D, F.lane, nya); raw_load_bf16(ym_ + (size_t)((row_) * 2 + 1) * D, F.lane, nyb); \
               ng0 = gt_[(size_t)(row_) * 2]; ng1 = gt_[(size_t)(row_) * 2 + 1]; } } while (0)
      R2_LOAD(blk * 128 + F.wave * 16);
      for (int i = 0; i < 16; ++i) { const int row = blk * 128 + F.wave * 16 + i, b = row >> 11; f32x4 x[4], yy[4];
        raw_cvt_bf16(nxb, x);
        if (!moe) raw_cvt_bf16(nya, yy);
        else { f32x4 ya[4], yb[4]; raw_cvt_bf16(nya, ya); raw_cvt_bf16(nyb, yb); const float g0 = ng0, g1 = ng1;
#pragma unroll
            for (int j = 0; j < 4; ++j) yy[j] = ya[j] * g0 + yb[j] * g1; }
        if (i < 15) R2_LOAD(row + 1);
        resid_update(x, yy, vg3, vgt, F.lane); (void)b;
        if (l + 1 < DEPTH) row_store_bf16((bf16*)(F.ws + WS_XB) + (size_t)row * D, F.lane, x); else row_store_f32(F.out + (size_t)row * D, F.lane, x);
        if (l + 1 < DEPTH) { f32x4 h[4]; mod_norm_store(x, vgn, vsh, vsc, hb + (size_t)row * D, F.lane, h); }
      } }
#undef R2_LOAD
}

DI void phase_fix(Frame& F, KArgs a, int l) {
    const bf16* P1 = (const bf16*)(F.ws + WS_P1); const bf16* P2 = (const bf16*)(F.ws + WS_P2);
    const int gw = F.cu * NWAVES + F.wave, NGW = F.G * NWAVES;
    float* bt2 = (float*)(F.ws + WS_BT2); float* a2 = (float*)(F.ws + WS_A2);
    for (int it = F.cu; it < 96; it += F.G) { const int b = it / 6, h = it % 6; const float bi = IN(I_BIG)[l * 6 + h], bfg = IN(I_BFG)[l * 6 + h];
        LAS float* wt = (LAS float*)F.lds;
        const int t0 = F.wave * 256 + F.lane * 4; float lf[4], ig[4]; float tot = 0.f;
#pragma unroll
        for (int i = 0; i < 4; ++i) { const size_t row = (size_t)b * SEQ + t0 + i; const float fg = bf2f(P2[row * 1024 + 774 + h]) + bfg; ig[i] = bf2f(P2[row * 1024 + 768 + h]) + bi;
            const float ls = (fg >= 0.f) ? -__logf(1.f + __expf(-fg)) : fg - __logf(1.f + __expf(fg)); tot += ls; lf[i] = tot; }
        float incl = tot;
#pragma unroll
        for (int o = 1; o < 64; o <<= 1) { const float t = lane_read(incl, F.lane - o); if (F.lane >= o) incl += t; }
        const float excl = incl - tot;
        if (F.lane == 63) wt[F.wave] = incl;
        __syncthreads();
        float base = 0.f;
        for (int w2 = 0; w2 < F.wave; ++w2) base += wt[w2];
        f32x4 Bv, Av;
#pragma unroll
        for (int i = 0; i < 4; ++i) { const float B = (base + excl + lf[i]) * LOG2E; Bv[i] = B; Av[i] = ig[i] * LOG2E - B; }
        const size_t o = (size_t)it * SEQ + t0; *(GAS f32x4*)(bt2 + o) = Bv; *(GAS f32x4*)(a2 + o) = Av;
        __syncthreads();
    }
    bf16* cqn = (bf16*)(F.ws + WS_CQN); bf16* ckvn = (bf16*)(F.ws + WS_CKVN); bf16* kc = (bf16*)(F.ws + WS_KC); bf16* qbc = (bf16*)(F.ws + WS_QBC); bf16* kbc = (bf16*)(F.ws + WS_KBC);
    const float* cs = (const float*)(F.ws + WS_CS);
    const float* wconv = IN(I_WCONV) + (size_t)l * 4 * 768; const float* bconv = IN(I_BCONV) + (size_t)l * 768;
    for (int run = gw; run < NTOK / 16; run += NGW) {
    const int row0 = run * 16; u32x2 pv[3][3]; f32x4 wcv[4][3], bcv[3];
#pragma unroll
    for (int g = 0; g < 3; ++g) { const int ch = (g * 64 + F.lane) * 4; bcv[g] = *(const GAS f32x4*)(bconv + ch);
#pragma unroll
        for (int j = 0; j < 4; ++j) wcv[j][g] = *(const GAS f32x4*)(wconv + j * 768 + ch);
#pragma unroll
        for (int j = 0; j < 3; ++j) { pv[j][g] = (u32x2){0u, 0u}; if ((row0 & (SEQ - 1)) - 3 + j >= 0) pv[j][g] = *(const GAS u32x2*)(P2 + (size_t)(row0 - 3 + j) * 1024 + ch); } }
    f32x4 gq4 = {0.f, 0.f, 0.f, 0.f}; if (F.lane < 48) gq4 = *(const GAS f32x4*)(IN(I_GQL) + l * 192 + 4 * F.lane);
    const f32x2 gk2 = *(const GAS f32x2*)(IN(I_GKVL) + l * 128 + 2 * F.lane);
    const int kg = (F.lane >> 2) & 3, kj = F.lane & 3;
    u32x2 n_cq = {0u, 0u}, n_cur[3]; unsigned n_ckv; unsigned short n_u1, n_u2; float n_c, n_sn;
#define FIX_LOAD(row_) do { const size_t r_ = (size_t)(row_); n_cq = (u32x2){0u, 0u}; if (F.lane < 48) n_cq = *(const GAS u32x2*)(P2 + r_ * 1024 + 784 + 4 * F.lane); \
        n_ckv = *(const GAS unsigned*)(P1 + r_ * 1024 + 896 + 2 * F.lane); \
        n_u1 = *(const GAS unsigned short*)(P2 + r_ * 1024 + 976 + kg * 8 + kj); n_u2 = *(const GAS unsigned short*)(P2 + r_ * 1024 + 976 + kg * 8 + 4 + kj); \
        n_c = cs[r_ * 32 + kg * 4 + kj]; n_sn = cs[r_ * 32 + 16 + kg * 4 + kj]; \
        _Pragma("unroll") for (int g_ = 0; g_ < 3; ++g_) n_cur[g_] = *(const GAS u32x2*)(P2 + r_ * 1024 + (g_ * 64 + F.lane) * 4); } while (0)
    FIX_LOAD(row0);
    for (int ri = 0; ri < 16; ++ri) { const int row = row0 + ri;
        const u32x2 w_cq = n_cq; const unsigned w_ckv = n_ckv; const float u1 = bf2f(n_u1), u2 = bf2f(n_u2), c = n_c, sn = n_sn; u32x2 curv[3];
#pragma unroll
        for (int g = 0; g < 3; ++g) curv[g] = n_cur[g];
        if (ri < 15) FIX_LOAD(row + 1);
        { const float v0 = bflo(w_cq.x), v1 = bfhi(w_cq.x), v2 = bflo(w_cq.y), v3 = bfhi(w_cq.y), k0 = bflo(w_ckv), k1 = bfhi(w_ckv);
          float sq = v0 * v0 + v1 * v1 + v2 * v2 + v3 * v3, sk = k0 * k0 + k1 * k1; wave_sum2(sq, sk, F.lane);
          const float rq = rsqrtf(sq * (1.f / 192.f) + EPS), rk = rsqrtf(sk * (1.f / 128.f) + EPS);
          u32x2 o; o.x = cvtpk(v0 * rq * gq4.x, v1 * rq * gq4.y); o.y = cvtpk(v2 * rq * gq4.z, v3 * rq * gq4.w); *(GAS u32x2*)(cqn + (size_t)row * 256 + 4 * F.lane) = o;
          *(GAS unsigned*)(ckvn + (size_t)row * 128 + 2 * F.lane) = cvtpk(k0 * rk * gk2.x, k1 * rk * gk2.y); }
        { const int g = kg, j = kj; const float o1 = u1 * c - u2 * sn, o2 = u1 * sn + u2 * c;
          if (F.lane < 16) {
#pragma unroll
              for (int h = 0; h < 6; ++h) { kc[(size_t)row * 576 + h * 96 + 64 + g * 8 + j] = (bf16)(cvtpk(o1, 0.f) & 0xffffu); kc[(size_t)row * 576 + h * 96 + 64 + g * 8 + 4 + j] = (bf16)(cvtpk(o2, 0.f) & 0xffffu); } } }
#pragma unroll
        for (int g = 0; g < 3; ++g) { const int ch = (g * 64 + F.lane) * 4; float accv[4];
            const u32x2 cur = curv[g];
#pragma unroll
            for (int q = 0; q < 4; ++q) accv[q] = bcv[g][q];
#pragma unroll
            for (int j = 0; j < 4; ++j) { const u32x2 w = (j < 3) ? pv[j][g] : cur; const f32x4 wc = wcv[j][g];
                accv[0] += bflo(w.x) * wc.x; accv[1] += bfhi(w.x) * wc.y; accv[2] += bflo(w.y) * wc.z; accv[3] += bfhi(w.y) * wc.w; }
            pv[0][g] = pv[1][g]; pv[1][g] = pv[2][g]; pv[2][g] = cur;
            const float sc = (ch >= 384) ? 0.125f : 1.0f;
            u32x2 o; o.x = cvtpk(siluf(accv[0]) * sc, siluf(accv[1]) * sc); o.y = cvtpk(siluf(accv[2]) * sc, siluf(accv[3]) * sc);
            if (ch < 384) *(GAS u32x2*)(qbc + (size_t)row * 384 + ch) = o; else *(GAS u32x2*)(kbc + (size_t)row * 384 + ch - 384) = o; }
#undef FIX_LOAD
    } }
}

#define MFMA32(a, b, c) __builtin_amdgcn_mfma_f32_32x32x16_bf16((a), (b), (c), 0, 0, 0)
template <int DQK> struct AttnLds { static constexpr int KP = DQK + 8; static constexpr int KBYTES = 64 * KP * 2; static constexpr int VP = 68, VBYTES = 64 * VP * 2; };
constexpr int ATT_K_OFF = 0, ATT_V_OFF = 40960, ATT_G_OFF = 61440;

template <int DQK> DI void attn_qk(const LAS unsigned char* Kb, const bf16x8 (&qf)[DQK / 16], f32x16& s0, f32x16& s1, int r32, int hi) {
    typedef AttnLds<DQK> L; constexpr int KS = DQK / 16;
    s0 = f32x16{}; s1 = f32x16{};
    constexpr int BS = (KS > 2) ? 2 : KS;
#pragma unroll
    for (int b0 = 0; b0 < KS; b0 += BS) { bf16x8 k0[BS], k1[BS];
#pragma unroll
        for (int i = 0; i < BS; ++i) { k0[i] = *(const LAS bf16x8*)(Kb + (r32 * L::KP + (b0 + i) * 16 + hi * 8) * 2); k1[i] = *(const LAS bf16x8*)(Kb + ((32 + r32) * L::KP + (b0 + i) * 16 + hi * 8) * 2); }
        __builtin_amdgcn_sched_barrier(0);
#pragma unroll
        for (int i = 0; i < BS; ++i) { s0 = MFMA32(k0[i], qf[b0 + i], s0); s1 = MFMA32(k1[i], qf[b0 + i], s1); }
        __builtin_amdgcn_sched_barrier(0); }
}
template <int DQK, bool MLSTM>
DI void attn_sm_pv(f32x16& s0, f32x16& s1, const LAS unsigned char* Vb, const LAS float* gs, f32x16 (&o)[2], float& lsum, float& mrun, float cscale, float bt2q, bool diag, int tq, int r32, int hi) {
    typedef AttnLds<DQK> L;
    if (!MLSTM) {
        float mx = s0[0];
#pragma unroll
        for (int r = 1; r < 16; ++r) mx = fmaxf(mx, s0[r]);
#pragma unroll
        for (int r = 0; r < 16; ++r) mx = fmaxf(mx, s1[r]);
        mx = half_swap_max(mx);
        if (__builtin_amdgcn_ballot_w64(mx > mrun) != 0ull) {
            const float mnew = fmaxf(mrun, mx), alpha = __builtin_amdgcn_exp2f((mrun - mnew) * cscale); mrun = mnew; lsum *= alpha;
#pragma unroll
            for (int r = 0; r < 16; ++r) { o[0][r] *= alpha; o[1][r] *= alpha; } }
        const float mc = mrun * cscale; float ps = 0.f;
#ifdef ATT_DBL_SM
        { f32x16 t0 = s0, t1 = s1; float mx2 = t0[0];
#pragma unroll
          for (int r = 1; r < 16; ++r) mx2 = fmaxf(mx2, t0[r] * 1.0001f);
#pragma unroll
          for (int r = 0; r < 16; ++r) mx2 = fmaxf(mx2, t1[r] * 1.0001f);
          float ps2 = mx2;
#pragma unroll
          for (int r = 0; r < 16; ++r) { t0[r] = __builtin_amdgcn_exp2f(t0[r] * cscale - mc * 1.0001f); t1[r] = __builtin_amdgcn_exp2f(t1[r] * cscale - mc * 1.0001f); ps2 += t0[r] + t1[r]; }
          unsigned acc2 = 0;
#pragma unroll
          for (int r = 0; r < 16; r += 2) { acc2 ^= cvtpk(t0[r], t0[r + 1]); acc2 ^= cvtpk(t1[r], t1[r + 1]); }
          asm volatile("" :: "v"(ps2), "v"(acc2)); }
#endif
#pragma unroll
        for (int r = 0; r < 16; ++r) { s0[r] = __builtin_amdgcn_exp2f(s0[r] * cscale - mc); s1[r] = __builtin_amdgcn_exp2f(s1[r] * cscale - mc); ps += s0[r] + s1[r]; }
        lsum += ps;
    } else {
        float ps = 0.f;
#pragma unroll
        for (int g = 0; g < 4; ++g) { const f32x4 ga = *(const LAS f32x4*)(gs + 8 * g + 4 * hi), gb = *(const LAS f32x4*)(gs + 32 + 8 * g + 4 * hi);
#pragma unroll
            for (int q = 0; q < 4; ++q) { const int r = 4 * g + q, key = 8 * g + 4 * hi + q;
                float w0 = __builtin_amdgcn_exp2f(bt2q + ga[q]), w1 = __builtin_amdgcn_exp2f(bt2q + gb[q]);
                if (diag) { if (key > tq) w0 = 0.f; if (key + 32 > tq) w1 = 0.f; }
                s0[r] *= w0; s1[r] *= w1; ps += s0[r] + s1[r]; } }
        lsum += ps;
    }
    bf16x8 pf[4];
#pragma unroll
    for (int s = 0; s < 2; ++s) { u32x4 t0, t1;
        t0.x = cvtpk(s0[8 * s + 0], s0[8 * s + 1]); t0.y = cvtpk(s0[8 * s + 2], s0[8 * s + 3]); t0.z = cvtpk(s0[8 * s + 4], s0[8 * s + 5]); t0.w = cvtpk(s0[8 * s + 6], s0[8 * s + 7]);
        t1.x = cvtpk(s1[8 * s + 0], s1[8 * s + 1]); t1.y = cvtpk(s1[8 * s + 2], s1[8 * s + 3]); t1.z = cvtpk(s1[8 * s + 4], s1[8 * s + 5]); t1.w = cvtpk(s1[8 * s + 6], s1[8 * s + 7]);
        pf[s] = __builtin_bit_cast(bf16x8, t0); pf[2 + s] = __builtin_bit_cast(bf16x8, t1); }
    { u32x4 av0[4], av1[4];
#define ATT_VRD(dst, d) do { _Pragma("unroll") for (int kk = 0; kk < 4; ++kk) { const int kbase = 32 * (kk >> 1) + 16 * (kk & 1) + 4 * hi; const LAS unsigned char* vp = Vb + ((32 * (d) + r32) * L::VP + kbase) * 2; \
          const u32x2 lo = *(const LAS u32x2*)vp, hh = *(const LAS u32x2*)(vp + 16); dst[kk] = (u32x4){lo.x, lo.y, hh.x, hh.y}; } } while (0)
      ATT_VRD(av0, 0);
      __builtin_amdgcn_sched_barrier(0);
      ATT_VRD(av1, 1);
#pragma unroll
      for (int kk = 0; kk < 4; ++kk) o[0] = MFMA32(__builtin_bit_cast(bf16x8, av0[kk]), pf[kk], o[0]);
      __builtin_amdgcn_sched_barrier(0);
#pragma unroll
      for (int kk = 0; kk < 4; ++kk) o[1] = MFMA32(__builtin_bit_cast(bf16x8, av1[kk]), pf[kk], o[1]);
      __builtin_amdgcn_sched_barrier(0);
#undef ATT_VRD
    }
}
#define SB_ __builtin_amdgcn_sched_barrier(0)
template <int DQK, bool DOQK = true, bool CI = false>
DI void attn_step_fused(const LAS unsigned char* Kb, const bf16x8 (&qf)[DQK / 16], f32x16& n0, f32x16& n1, f32x16& s0, f32x16& s1, const LAS unsigned char* Vb, f32x16 (&o)[2], float& lsum, float& mrun, float cscale, int r32, int hi, f32x16* negm = nullptr) {
    typedef AttnLds<DQK> L; constexpr int KS = DQK / 16; static_assert(KS == 6 || KS == 4 || KS == 2, "");
    constexpr int FVP = 72;
    bf16x8 ka[2], kb[2]; u32x4 va[2][2]; bf16x8 pf[4];
#define FS_LDK(b0_) do { _Pragma("unroll") for (int i = 0; i < 2; ++i) { ka[i] = *(const LAS bf16x8*)(Kb + (r32 * L::KP + ((b0_) + i) * 16 + hi * 8) * 2); kb[i] = *(const LAS bf16x8*)(Kb + ((32 + r32) * L::KP + ((b0_) + i) * 16 + hi * 8) * 2); } } while (0)
#define FS_LDV(slot, kk) do { _Pragma("unroll") for (int d = 0; d < 2; ++d) va[slot][d] = *(const LAS u32x4*)(Vb + ((32 * d + r32) * FVP + 16 * (kk) + 8 * hi) * 2); } while (0)
#define FS_EXPG(S, r) do { if constexpr (CI) { S[r] = __builtin_amdgcn_exp2f(S[r]); S[(r) + 1] = __builtin_amdgcn_exp2f(S[(r) + 1]); } \
        else { S[r] = __builtin_amdgcn_exp2f(S[r] * cscale - mc); S[(r) + 1] = __builtin_amdgcn_exp2f(S[(r) + 1] * cscale - mc); } ps += S[r] + S[(r) + 1]; } while (0)
#define FS_CVT(dst, S, r) do { u32x4 t_; t_.x = cvtpk(S[(r) + 0], S[(r) + 1]); t_.y = cvtpk(S[(r) + 2], S[(r) + 3]); t_.z = cvtpk(S[(r) + 4], S[(r) + 5]); t_.w = cvtpk(S[(r) + 6], S[(r) + 7]); dst = __builtin_bit_cast(bf16x8, t_); } while (0)
#define FS_PV(kk, d, slot) do { o[d] = MFMA32(__builtin_bit_cast(bf16x8, va[slot][d]), pf[kk], o[d]); } while (0)
    if constexpr (DOQK) { FS_LDK(0); } SB_;
    float mx = s0[0];
#pragma unroll
    for (int r = 1; r < 16; ++r) mx = fmaxf(mx, s0[r]);
#pragma unroll
    for (int r = 0; r < 16; ++r) mx = fmaxf(mx, s1[r]);
    mx = half_swap_max(mx);
    SB_;
    if constexpr (CI) {
        if (__builtin_amdgcn_ballot_w64(mx > 8.f) != 0ull) {
            const float delta = mx > 8.f ? mx : 0.f, alpha = __builtin_amdgcn_exp2f(-delta); lsum *= alpha;
#pragma unroll
            for (int r = 0; r < 16; ++r) { o[0][r] *= alpha; o[1][r] *= alpha; s0[r] -= delta; s1[r] -= delta; (*negm)[r] -= delta; } }
        SB_;
        if constexpr (DOQK) { n0 = MFMA32(ka[0], qf[0], *negm); SB_; n1 = MFMA32(kb[0], qf[0], *negm); SB_; }
    } else {
    if constexpr (DOQK) { n0 = MFMA32(ka[0], qf[0], f32x16{}); SB_;
    n1 = MFMA32(kb[0], qf[0], f32x16{}); SB_; }
    if (__builtin_amdgcn_ballot_w64((mx - mrun) * cscale > 8.f) != 0ull) {
        const float mnew = ((mx - mrun) * cscale > 8.f) ? mx : mrun, alpha = __builtin_amdgcn_exp2f((mrun - mnew) * cscale); mrun = mnew; lsum *= alpha;
#pragma unroll
        for (int r = 0; r < 16; ++r) { o[0][r] *= alpha; o[1][r] *= alpha; } }
    }
    const float mc = mrun * cscale; float ps = 0.f; (void)mc;
    SB_;
    if constexpr (DOQK) { n0 = MFMA32(ka[1], qf[1], n0); SB_; }
    FS_EXPG(s0, 0); SB_;
    if constexpr (DOQK) { n1 = MFMA32(kb[1], qf[1], n1); SB_; }
    if constexpr (DOQK && KS >= 4) { FS_LDK(2); } FS_LDV(0, 0); SB_;
    FS_EXPG(s0, 2); FS_EXPG(s0, 4); FS_EXPG(s0, 6); SB_;
    FS_CVT(pf[0], s0, 0); SB_;
    if constexpr (DOQK && KS >= 4) {
        n0 = MFMA32(ka[0], qf[2], n0); SB_; FS_EXPG(s0, 8); SB_;
        n1 = MFMA32(kb[0], qf[2], n1); SB_; FS_EXPG(s0, 10); SB_;
        n0 = MFMA32(ka[1], qf[3], n0); SB_; FS_EXPG(s0, 12); SB_;
        n1 = MFMA32(kb[1], qf[3], n1); SB_; FS_EXPG(s0, 14); SB_;
    } else { FS_EXPG(s0, 8); FS_EXPG(s0, 10); FS_EXPG(s0, 12); FS_EXPG(s0, 14); SB_; }
    if constexpr (DOQK && KS >= 6) { FS_LDK(4); } FS_LDV(1, 1); SB_;
    FS_CVT(pf[1], s0, 8); SB_;
    FS_PV(0, 0, 0); SB_; FS_EXPG(s1, 0); SB_;
    FS_PV(0, 1, 0); SB_; FS_EXPG(s1, 2); SB_;
    FS_LDV(0, 2); SB_;
    if constexpr (DOQK && KS >= 6) {
        n0 = MFMA32(ka[0], qf[4], n0); SB_; FS_EXPG(s1, 4); SB_;
        n1 = MFMA32(kb[0], qf[4], n1); SB_; FS_EXPG(s1, 6); SB_;
        n0 = MFMA32(ka[1], qf[5], n0); SB_; FS_CVT(pf[2], s1, 0); SB_;
        n1 = MFMA32(kb[1], qf[5], n1); SB_; FS_EXPG(s1, 8); SB_;
    } else { FS_EXPG(s1, 4); FS_EXPG(s1, 6); SB_; FS_CVT(pf[2], s1, 0); SB_; FS_EXPG(s1, 8); SB_; }
    FS_PV(1, 0, 1); SB_; FS_EXPG(s1, 10); SB_;
    FS_PV(1, 1, 1); SB_; FS_EXPG(s1, 12); SB_;
    FS_LDV(1, 3); SB_;
    FS_PV(2, 0, 0); SB_; FS_EXPG(s1, 14); SB_;
    FS_PV(2, 1, 0); SB_; FS_CVT(pf[3], s1, 8); lsum += ps; SB_;
    FS_PV(3, 0, 1); SB_;
    FS_PV(3, 1, 1); SB_;
#undef FS_LDK
#undef FS_LDV
#undef FS_EXPG
#undef FS_CVT
#undef FS_PV
}
template <int DQK, bool MLSTM>
DI void attn_pass(Frame& F, const bf16* Qp, int qpitch, const bf16* Kp, int kpitch, const bf16* Vt, const float* a2g  , float bt2q, int b, int qb, float cscale,
                  f32x16 (&o)[2], float& lsum, int t0 = 0  ) {
    typedef AttnLds<DQK> L;
    constexpr bool CIM = !MLSTM && ATT_FUSED && ATT_CINIT;
    constexpr bool VPM = !MLSTM && ATT_FUSED; constexpr int VPx = VPM ? 72 : L::VP, VBx = 64 * VPx * 2;
    constexpr int KS = DQK / 16, KPIECES = 64 * DQK / 8, KREG = (KPIECES + NTHR - 1) / NTHR;
    const int lane = F.lane, r32 = lane & 31, hi = lane >> 5, w = F.wave;
    const int NT = 4 * qb + 4, myc = 4 * qb + (w >> 1);
    LAS unsigned char* lds = F.lds;
    bf16x8 qf[KS];
    { const bf16* qrow = Qp + (size_t)(b * SEQ + qb * 256 + w * 32 + r32) * qpitch;
#pragma unroll
      for (int ks = 0; ks < KS; ++ks) qf[ks] = *(const GAS bf16x8*)(qrow + ks * 16 + hi * 8); }
    o[0] = f32x16{}; o[1] = f32x16{}; lsum = 0.f; float mrun = -INFINITY; f32x16 negm = f32x16{};
    u32x4 kregA[KREG], vregA, kregB[KREG], vregB; float gregA = 0.f, gregB = 0.f;
    const int vrow = F.tid >> 3, vc = F.tid & 7, tq = (w & 1) * 32 + r32;
    unsigned koff[KREG];
#pragma unroll
    for (int q_ = 0; q_ < KREG; ++q_) { const int p_ = (F.tid + q_ * NTHR < KPIECES) ? F.tid + q_ * NTHR : F.tid, row_ = p_ / (DQK / 8), c_ = p_ % (DQK / 8); koff[q_] = (unsigned)(row_ * kpitch + c_ * 8) * 2u; }
    const unsigned voff = (unsigned)(((F.tid >> 3) * NTOK + (F.tid & 7) * 8) * 2);
    const char* const wsb = (const char*)F.ws;
    const unsigned kb32 = (unsigned)((const char*)Kp - wsb) + (unsigned)b * (unsigned)(SEQ * 2) * (unsigned)kpitch, vb32 = (unsigned)((const char*)Vt - wsb) + (unsigned)b * (unsigned)(SEQ * 2);
#define ATT_LOADK(KR, kt) do { const unsigned kt_ = kb32 + (unsigned)(kt) * (unsigned)(64 * 2) * (unsigned)kpitch; \
        _Pragma("unroll") for (int q_ = 0; q_ < KREG; ++q_) KR[q_] = *(const GAS u32x4*)(wsb + (size_t)(kt_ + koff[q_])); } while (0)
#define ATT_WRITEK(KR, kbuf) do { \
        _Pragma("unroll") for (int q_ = 0; q_ < KREG; ++q_) { const int p_ = F.tid + q_ * NTHR; if (p_ < KPIECES) { const int row_ = p_ / (DQK / 8), c_ = p_ % (DQK / 8); \
            *(LAS u32x4*)(lds + ATT_K_OFF + (kbuf) * 13312 + (row_ * L::KP + c_ * 8) * 2) = KR[q_]; } } } while (0)
#define ATT_LOAD(KR, VR, GR, j) do { ATT_LOADK(KR, ((j) + 1 < NT) ? (j) + 1 : NT - 1); \
        VR = *(const GAS u32x4*)(wsb + (size_t)(vb32 + (unsigned)(j) * 128u + voff)); \
        if constexpr (MLSTM) GR = a2g[(j) * 64 + (F.tid & 63)]; } while (0)
#define ATT_WRITE(KR, VR, GR, buf) do { ATT_WRITEK(KR, buf); \
        { LAS u32x2* vp_ = (LAS u32x2*)(lds + ATT_V_OFF + (buf) * VBx + (vrow * VPx + (VPM ? (vc >> 1) * 16 + (vc & 1) * 4 : vc * 8)) * 2); vp_[0] = (u32x2){VR.x, VR.y}; vp_[VPM ? 2 : 1] = (u32x2){VR.z, VR.w}; } \
        if (MLSTM && F.tid < 64) *(LAS float*)(lds + ATT_G_OFF + (buf) * 256 + F.tid * 4) = GR; } while (0)
#define ATT_STEP(j, buf, SC0, SC1, SN0, SN1) do { \
        if constexpr (!MLSTM && ATT_FUSED) {   \
            if ((j) <= myc) attn_step_fused<DQK, true, CIM>(lds + ATT_K_OFF + (buf) * 13312, qf, SN0, SN1, SC0, SC1, lds + ATT_V_OFF + (buf) * VBx, o, lsum, mrun, cscale, r32, hi, &negm); } \
        else { \
        if ((j) + 1 <= myc) { ATT_DBLQK(buf); attn_qk<DQK>(lds + ATT_K_OFF + (buf) * 13312, qf, SN0, SN1, r32, hi); } \
        if ((j) <= myc) attn_sm_pv<DQK, MLSTM>(SC0, SC1, lds + ATT_V_OFF + (buf) * L::VBYTES, (const LAS float*)(lds + ATT_G_OFF + (buf) * 256), o, lsum, mrun, cscale, bt2q, (j) == myc, tq, r32, hi); } } while (0)
#ifdef ATT_DBL_QK
#define ATT_DBLQK(buf) do { f32x16 t0_, t1_; attn_qk<DQK>(lds + ATT_K_OFF + (buf) * 13312, qf, t0_, t1_, r32, hi); asm volatile("" :: "v"(t0_), "v"(t1_)); } while (0)
#else
#define ATT_DBLQK(buf) do {} while (0)
#endif
    f32x16 sa0, sa1, sb0, sb1;
    ATT_LOADK(kregB, t0); ATT_LOAD(kregA, vregA, gregA, t0);
    ATT_WRITEK(kregB, 2); ATT_WRITE(kregA, vregA, gregA, 0);
    ATT_LOAD(kregA, vregA, gregA, t0 + 1);
    __syncthreads();
    attn_qk<DQK>(lds + ATT_K_OFF + 2 * 13312, qf, sa0, sa1, r32, hi);
    if constexpr (CIM) { float mx = sa0[0];
#pragma unroll
        for (int r = 1; r < 16; ++r) mx = fmaxf(mx, sa0[r]);
#pragma unroll
        for (int r = 0; r < 16; ++r) mx = fmaxf(mx, sa1[r]);
        mx = half_swap_max(mx);
#pragma unroll
        for (int r = 0; r < 16; ++r) { sa0[r] -= mx; sa1[r] -= mx; negm[r] = -mx; } }
    if (w >= 4) __builtin_amdgcn_s_setprio(1);
    for (int j = t0; j < NT; j += 2) {
        ATT_LOAD(kregB, vregB, gregB, (j + 2 < NT) ? j + 2 : NT - 1);
        ATT_STEP(j, 0, sa0, sa1, sb0, sb1);
        ATT_WRITE(kregA, vregA, gregA, 1);
        __syncthreads();
        ATT_LOAD(kregA, vregA, gregA, (j + 3 < NT) ? j + 3 : NT - 1);
        ATT_STEP(j + 1, 1, sb0, sb1, sa0, sa1);
        if (j + 2 < NT) ATT_WRITE(kregB, vregB, gregB, 0);
        __syncthreads();
    }
    __builtin_amdgcn_s_setprio(0);
#undef ATT_LOADK
#undef ATT_WRITEK
#undef ATT_LOAD
#undef ATT_WRITE
#undef ATT_STEP
}
DI void attn_pass_diff(Frame& F, const bf16* P1h  , const bf16* Vt, int b, int qb, float cscale,
                       f32x16 (&o1)[2], float& l1, f32x16 (&o2)[2], float& l2) {
    typedef AttnLds<32> L;
    int lane = F.lane; asm volatile("" : "+v"(lane));
    const int r32 = lane & 31, hi = lane >> 5, w = F.wave, tid = w * 64 + lane;
    const int NT = 4 * qb + 4, myc = 4 * qb + (w >> 1);
    LAS unsigned char* lds = F.lds;
    bf16x8 qf1[2], qf2[2];
    { const bf16* qrow = P1h + (size_t)(b * SEQ + qb * 256 + w * 32 + r32) * 1024;
#pragma unroll
      for (int ks = 0; ks < 2; ++ks) { qf1[ks] = *(const GAS bf16x8*)(qrow + ks * 16 + hi * 8); qf2[ks] = *(const GAS bf16x8*)(qrow + 128 + ks * 16 + hi * 8); } }
    o1[0] = f32x16{}; o1[1] = f32x16{}; o2[0] = f32x16{}; o2[1] = f32x16{}; l1 = 0.f; l2 = 0.f; float m1 = -INFINITY, m2 = -INFINITY;
    const int which = tid >> 8, kp = tid & 255, krow = kp >> 2, kc = kp & 3, vrow = tid >> 3, vc = tid & 7;
    const unsigned koff = (unsigned)((256 + which * 128 + krow * 1024 + kc * 8) * 2), voff = (unsigned)((vrow * NTOK + vc * 8) * 2);
    constexpr bool VPM = ATT_FUSED != 0; constexpr int VPx = VPM ? 72 : L::VP, VBx = 64 * VPx * 2;
    const unsigned kdst = (unsigned)(which * 6144 + (krow * L::KP + kc * 8) * 2), vdst = (unsigned)((vrow * VPx + (VPM ? (vc >> 1) * 16 + (vc & 1) * 4 : vc * 8)) * 2);
    const char* const wsb = (const char*)F.ws;
    const unsigned kb32 = (unsigned)((const char*)P1h - wsb) + (unsigned)b * (unsigned)(SEQ * 2048), vb32 = (unsigned)((const char*)Vt - wsb) + (unsigned)b * (unsigned)(SEQ * 2);
    u32x4 kA, vA;
#define AD_LOAD(KR, VR, j) do { KR = *(const GAS u32x4*)(wsb + (size_t)(kb32 + (unsigned)(j) * (64u * 2048u) + koff)); VR = *(const GAS u32x4*)(wsb + (size_t)(vb32 + (unsigned)(j) * 128u + voff)); } while (0)
#define AD_WRITE(KR, VR, buf) do { *(LAS u32x4*)(lds + ATT_K_OFF + (buf) * 13312 + kdst) = KR; \
        { LAS u32x2* vp_ = (LAS u32x2*)(lds + ATT_V_OFF + (buf) * VBx + vdst); vp_[0] = (u32x2){VR.x, VR.y}; vp_[VPM ? 2 : 1] = (u32x2){VR.z, VR.w}; } } while (0)
#if ATT_FUSED
#define AD_STEP(j, buf) do { if ((j) <= myc) { f32x16 s0, s1, t0, t1; \
        attn_qk<32>(lds + ATT_K_OFF + (buf) * 13312, qf1, s0, s1, r32, hi); \
        attn_step_fused<32, true>(lds + ATT_K_OFF + (buf) * 13312 + 6144, qf2, t0, t1, s0, s1, lds + ATT_V_OFF + (buf) * VBx, o1, l1, m1, cscale, r32, hi);     \
        attn_step_fused<32, false>(lds, qf2, s0, s1, t0, t1, lds + ATT_V_OFF + (buf) * VBx, o2, l2, m2, cscale, r32, hi); } } while (0)
#else
#define AD_STEP(j, buf) do { if ((j) <= myc) { f32x16 s0, s1; \
        attn_qk<32>(lds + ATT_K_OFF + (buf) * 13312, qf1, s0, s1, r32, hi); \
        attn_sm_pv<32, false>(s0, s1, lds + ATT_V_OFF + (buf) * L::VBYTES, nullptr, o1, l1, m1, cscale, 0.f, false, 0, r32, hi); \
        attn_qk<32>(lds + ATT_K_OFF + (buf) * 13312 + 6144, qf2, s0, s1, r32, hi); \
        attn_sm_pv<32, false>(s0, s1, lds + ATT_V_OFF + (buf) * L::VBYTES, nullptr, o2, l2, m2, cscale, 0.f, false, 0, r32, hi); } } while (0)
#endif
    AD_LOAD(kA, vA, 0); AD_WRITE(kA, vA, 0);
    __syncthreads();
    if (w >= 4) __builtin_amdgcn_s_setprio(1);
    for (int j = 0; j < NT; j += 2) {
        AD_LOAD(kA, vA, j + 1);
        AD_STEP(j, 0);
        AD_WRITE(kA, vA, 1);
        __syncthreads();
        AD_LOAD(kA, vA, (j + 2 < NT) ? j + 2 : NT - 1);
        AD_STEP(j + 1, 1);
        if (j + 2 < NT) AD_WRITE(kA, vA, 0);
        __syncthreads();
    }
    __builtin_amdgcn_s_setprio(0);
#undef AD_LOAD
#undef AD_WRITE
#undef AD_STEP
}
DI void attn_store(bf16* orow, int hi, const f32x16 (&v)[2]) {
#pragma unroll
    for (int d = 0; d < 2; ++d)
#pragma unroll
        for (int g = 0; g < 4; ++g) { u32x2 w; w.x = cvtpk(v[d][4 * g], v[d][4 * g + 1]); w.y = cvtpk(v[d][4 * g + 2], v[d][4 * g + 3]); *(GAS u32x2*)(orow + 32 * d + 8 * g + 4 * hi) = w; }
}
constexpr int MS_K = 0, MS_V = 36864, MS_G = 71680, MS_RED = 0, MS_REDN = 65536;
DI void mlstm_state_unit(Frame& F, int bh, int blk) {
    const int b = bh / 6, h = bh % 6, lane = F.lane, r32 = lane & 31, hi = lane >> 5, w = F.wave, p = w >> 1, dh = w & 1, ptid = F.tid & 127, tl = 4 * blk + p;
    LAS unsigned char* lds = F.lds;
    const bf16* kbc = (const bf16*)(F.ws + WS_KBC) + (size_t)(b * SEQ + tl * 64) * 384 + h * 64;
    const bf16* vt = (const bf16*)(F.ws + WS_VTAB) + (size_t)(256 + h * 64) * NTOK + b * SEQ + tl * 64;
    const float* bt2 = (const float*)(F.ws + WS_BT2) + (size_t)bh * SEQ; const float* a2 = (const float*)(F.ws + WS_A2) + (size_t)bh * SEQ;
    { u32x4 kr[4], vr[4];
#pragma unroll
      for (int i = 0; i < 4; ++i) { const int q = ptid + 128 * i, row = q >> 3, c = q & 7; kr[i] = *(const GAS u32x4*)(kbc + (size_t)row * 384 + c * 8); vr[i] = *(const GAS u32x4*)(vt + (size_t)row * NTOK + c * 8); }
      const float g = (ptid < 64) ? a2[tl * 64 + ptid] : 0.f;
#pragma unroll
      for (int i = 0; i < 4; ++i) { const int q = ptid + 128 * i, row = q >> 3, c = q & 7;
          *(LAS u32x4*)(lds + MS_K + p * 9216 + (row * 72 + c * 8) * 2) = kr[i];
          LAS u32x2* vp = (LAS u32x2*)(lds + MS_V + p * 8704 + (row * 68 + c * 8) * 2); vp[0] = (u32x2){vr[i].x, vr[i].y}; vp[1] = (u32x2){vr[i].z, vr[i].w}; }
      if (ptid < 64) *(LAS float*)(lds + MS_G + p * 256 + ptid * 4) = g; }
    __syncthreads();
    bf16x8 qf[4]; const int col = 32 * dh + r32;
#pragma unroll
    for (int ks = 0; ks < 4; ++ks)
#pragma unroll
        for (int j = 0; j < 8; ++j) qf[ks][j] = (16 * ks + 8 * hi + j == col) ? (short)0x3F80 : (short)0;
    f32x16 s0, s1, o[2]; o[0] = f32x16{}; o[1] = f32x16{}; float lsum = 0.f, mrun = 0.f;
    attn_qk<64>(lds + MS_K + p * 9216, qf, s0, s1, r32, hi);
    attn_sm_pv<64, true>(s0, s1, lds + MS_V + p * 8704, (const LAS float*)(lds + MS_G + p * 256), o, lsum, mrun, 0.f, bt2[blk * 256 + 255], false, 0, r32, hi);
    lsum = half_swap_sum(lsum);
    __syncthreads();
    LAS float* red = (LAS float*)(lds + MS_RED) + p * 4096; LAS float* redn = (LAS float*)(lds + MS_REDN) + p * 64;
#pragma unroll
    for (int d = 0; d < 2; ++d)
#pragma unroll
        for (int r = 0; r < 16; ++r) red[(32 * d + (r & 3) + 8 * (r >> 2) + 4 * hi) * 64 + col] = o[d][r];
    if (hi == 0) redn[col] = lsum;
    __syncthreads();
    { const LAS f32x4* r4 = (const LAS f32x4*)(lds + MS_RED) + F.tid * 2; f32x4 a0 = r4[0], a1 = r4[1];
#pragma unroll
      for (int q = 1; q < 4; ++q) { a0 += r4[q * 1024]; a1 += r4[q * 1024 + 1]; }
      GAS f32x4* dc = (GAS f32x4*)((float*)(F.ws + WS_DC) + ((size_t)bh * 7 + blk) * 4096) + F.tid * 2; dc[0] = a0; dc[1] = a1;
      if (F.tid < 64) { const LAS float* rn = (const LAS float*)(lds + MS_REDN) + F.tid; ((float*)(F.ws + WS_DN))[((size_t)bh * 7 + blk) * 64 + F.tid] = (rn[0] + rn[64]) + (rn[128] + rn[192]); } }
    __syncthreads();
}
DI void mlstm_state_phase(Frame& F) { for (int u = F.cu; u < 96 * 7; u += F.G) mlstm_state_unit(F, u / 7, u % 7); }
constexpr int MS_CS = 65536, MS_NS = 65536 + 9216;
DI void mlstm_inter(Frame& F, int bh, int qb, const bf16* qrow  , float bt2q, f32x16 (&o)[2], float& den) {
    int lane = F.lane; asm volatile("" : "+v"(lane));
    const int r32 = lane & 31, hi = lane >> 5, tid = F.wave * 64 + lane;
    LAS unsigned char* lds = F.lds;
    const float* bt2 = (const float*)(F.ws + WS_BT2) + (size_t)bh * SEQ;
    const float bref = bt2[qb * 256 - 1];
    { const int dv = tid >> 3, dk0 = (tid & 7) * 8; f32x4 c0 = {0.f, 0.f, 0.f, 0.f}, c1 = c0; float nacc = 0.f;
      for (int b0 = 0; b0 < qb; b0 += 4) { float bend[4]; f32x4 d0[4], d1[4]; float dnv[4];
#pragma unroll
          for (int i = 0; i < 4; ++i) { const int blk = (b0 + i < qb) ? b0 + i : qb - 1;
              bend[i] = bt2[blk * 256 + 255];
              const GAS f32x4* dc = (const GAS f32x4*)((const float*)(F.ws + WS_DC) + ((size_t)bh * 7 + blk) * 4096 + dv * 64 + dk0); d0[i] = dc[0]; d1[i] = dc[1];
              dnv[i] = (tid < 64) ? ((const float*)(F.ws + WS_DN))[((size_t)bh * 7 + blk) * 64 + tid] : 0.f; }
#pragma unroll
          for (int i = 0; i < 4; ++i) { const float d = (b0 + i < qb) ? __builtin_amdgcn_exp2f(bref - bend[i]) : 0.f; c0 += d0[i] * d; c1 += d1[i] * d; nacc += dnv[i] * d; } }
      u32x4 wv; wv.x = cvtpk(c0.x, c0.y); wv.y = cvtpk(c0.z, c0.w); wv.z = cvtpk(c1.x, c1.y); wv.w = cvtpk(c1.z, c1.w);
      *(LAS u32x4*)(lds + MS_CS + (dv * 72 + dk0) * 2) = wv;
      if (tid < 64) *(LAS float*)(lds + MS_NS + tid * 4) = nacc; }
    __syncthreads();
    bf16x8 qf[4];
#pragma unroll
    for (int ks = 0; ks < 4; ++ks) qf[ks] = *(const GAS bf16x8*)(qrow + ks * 16 + hi * 8);
    f32x16 i0, i1; attn_qk<64>(lds + MS_CS, qf, i0, i1, r32, hi);
    float dn = 0.f;
#pragma unroll
    for (int ks = 0; ks < 4; ++ks) { const f32x4 n0 = *(const LAS f32x4*)(lds + MS_NS + (16 * ks + 8 * hi) * 4), n1 = *(const LAS f32x4*)(lds + MS_NS + (16 * ks + 8 * hi + 4) * 4);
#pragma unroll
        for (int j = 0; j < 4; ++j) dn += bf2f((unsigned short)qf[ks][j]) * n0[j] + bf2f((unsigned short)qf[ks][4 + j]) * n1[j]; }
    dn = half_swap_sum(dn);
    const float u = __builtin_amdgcn_exp2f(bt2q - bref);
#pragma unroll
    for (int r = 0; r < 16; ++r) { o[0][r] += u * i0[r]; o[1][r] += u * i1[r]; }
    den += u * dn;
}
DI void attn_unit(Frame& F, KArgs a, int l, int mode, int bh, int qb) {
    const bf16* P1 = (const bf16*)(F.ws + WS_P1); bf16* mix = (bf16*)(F.ws + WS_HB);
    const int lane = F.lane, r32 = lane & 31, hi = lane >> 5;
    f32x16 o[2]; float lsum;
    if (mode == 0) {
        const int b = bh >> 2, h = bh & 3; const size_t row = (size_t)b * SEQ + qb * 256 + F.wave * 32 + r32;
        const bf16* Vt = (const bf16*)(F.ws + WS_VTAB) + (size_t)(h * 64) * NTOK; const float cs = 0.17677669529663687f * LOG2E;
        f32x16 o1[2]; float lsum1;
        attn_pass_diff(F, P1 + h * 32, Vt, b, qb, cs, o1, lsum1, o, lsum);
        f32x4 ggv[8]; { const float* gd_ = IN(I_GDIFF) + l * 64;
#pragma unroll
          for (int d = 0; d < 2; ++d)
#pragma unroll
              for (int g = 0; g < 4; ++g) ggv[d * 4 + g] = *(const GAS f32x4*)(gd_ + 32 * d + 8 * g + 4 * hi); }
        { const float inv = 1.f / half_swap_sum(lsum1);
#pragma unroll
          for (int d = 0; d < 2; ++d)
#pragma unroll
              for (int r = 0; r < 16; ++r) o1[d][r] *= inv; }
        float d1 = 0.f, d2 = 0.f;
        { const float* q1 = IN(I_LQ1) + l * 32, *k1 = IN(I_LK1) + l * 32, *q2 = IN(I_LQ2) + l * 32, *k2 = IN(I_LK2) + l * 32;
#pragma unroll 8
          for (int i = 0; i < 32; ++i) { d1 += q1[i] * k1[i]; d2 += q2[i] * k2[i]; } }
        const float lam_init = 0.8f - 0.6f * __expf(-0.3f * (float)l), lam = __expf(d1) - __expf(d2) + lam_init;
        const float inv2 = lam / half_swap_sum(lsum); float ss = 0.f;
#pragma unroll
        for (int d = 0; d < 2; ++d)
#pragma unroll
            for (int r = 0; r < 16; ++r) { o[d][r] = o1[d][r] - o[d][r] * inv2; ss += o[d][r] * o[d][r]; }
        const float rstd = rsqrtf(half_swap_sum(ss) * (1.f / 64.f) + EPS) * (1.f - lam_init);
#pragma unroll
        for (int d = 0; d < 2; ++d)
#pragma unroll
            for (int g = 0; g < 4; ++g) { const f32x4 gg = ggv[d * 4 + g];
#pragma unroll
                for (int q = 0; q < 4; ++q) o[d][4 * g + q] *= rstd * gg[q]; }
        attn_store(mix + row * D + h * 64, hi, o);
    } else if (mode == 1) {
        const int b = bh / 6, h = bh % 6; const size_t row = (size_t)b * SEQ + qb * 256 + F.wave * 32 + r32;
        const bf16* Vt = (const bf16*)(F.ws + WS_VTAB) + (size_t)(256 + h * 64) * NTOK;
        const float* bt2 = (const float*)(F.ws + WS_BT2) + (size_t)bh * SEQ; const float* a2 = (const float*)(F.ws + WS_A2) + (size_t)bh * SEQ;
        const float bt2q = bt2[qb * 256 + F.wave * 32 + r32];
        attn_pass<64, true>(F, (const bf16*)(F.ws + WS_QBC) + h * 64, 384, (const bf16*)(F.ws + WS_KBC) + h * 64, 384, Vt, a2, bt2q, b, qb, 0.f, o, lsum, 4 * qb);
        float den = half_swap_sum(lsum);
        const bf16* ob = P1 + row * 1024 + 512 + h * 64; const float* gm = IN(I_GML) + l * 384 + h * 64; u32x2 owv[8]; f32x4 ggv[8];
#pragma unroll
        for (int d = 0; d < 2; ++d)
#pragma unroll
            for (int g = 0; g < 4; ++g) { const int dv = 32 * d + 8 * g + 4 * hi; owv[d * 4 + g] = *(const GAS u32x2*)(ob + dv); ggv[d * 4 + g] = *(const GAS f32x4*)(gm + dv); }
        if (qb > 0) mlstm_inter(F, bh, qb, (const bf16*)(F.ws + WS_QBC) + row * 384 + h * 64, bt2q, o, den);
        const float inv = 1.f / fmaxf(fabsf(den), 1.f); float ss = 0.f;
#pragma unroll
        for (int d = 0; d < 2; ++d)
#pragma unroll
            for (int r = 0; r < 16; ++r) { o[d][r] *= inv; ss += o[d][r] * o[d][r]; }
        const float rstd = rsqrtf(half_swap_sum(ss) * (1.f / 64.f) + EPS);
#pragma unroll
        for (int d = 0; d < 2; ++d)
#pragma unroll
            for (int g = 0; g < 4; ++g) { const f32x4 gg = ggv[d * 4 + g]; const u32x2 ow = owv[d * 4 + g];
                const float og[4] = {bflo(ow.x), bfhi(ow.x), bflo(ow.y), bfhi(ow.y)};
#pragma unroll
                for (int q = 0; q < 4; ++q) o[d][4 * g + q] *= rstd * gg[q] * sigmoidf_(og[q]); }
        attn_store(mix + row * D + 256 + h * 64, hi, o);
    } else {
        const int b = bh / 6, h = bh % 6; const size_t row = (size_t)b * SEQ + qb * 256 + F.wave * 32 + r32;
        const bf16* Vt = (const bf16*)(F.ws + WS_VTC) + (size_t)(h * 64) * NTOK;
        attn_pass<96, false>(F, (const bf16*)(F.ws + WS_QC) + h * 96, 576, (const bf16*)(F.ws + WS_KC) + h * 96, 576, Vt, nullptr, 0.f, b, qb, 0.10206207261596577f * LOG2E, o, lsum);
        const float inv = 1.f / half_swap_sum(lsum);
#pragma unroll
        for (int d = 0; d < 2; ++d)
#pragma unroll
            for (int r = 0; r < 16; ++r) o[d][r] *= inv;
        attn_store(mix + row * D + 640 + h * 64, hi, o);
    }
}
DI void phase_attn(Frame& F, KArgs a, int l, int rep = 0) {
    volatile LAS int* slot = (volatile LAS int*)(F.lds + MISC_OFF + 256);
    for (;;) {
        __syncthreads();
        if (F.tid == 0) slot[0] = (int)__hip_atomic_fetch_add((unsigned*)(F.ctl + CW_ATTQ + 64 * l + 16 * rep), 1u, __ATOMIC_RELAXED, __HIP_MEMORY_SCOPE_AGENT);
        __syncthreads();
        int i = slot[0];
        if (l == 0) {
            if (i >= 2048 + TR_MOE_CHUNKS) break;
            if (i < 4 * TR_MOE_CHUNKS) {
                if (i % 4 == 3) { const int c = i / 4;
                    tr_run(F, a, TR_N_EARLY + c * TR_MOE_CHUNK + F.wave, TR_N_EARLY + (c + 1) * TR_MOE_CHUNK, NWAVES, (LAS float*)(F.lds + F.wave * 16384));
                    continue; }
                i -= i / 4; }
            else i -= TR_MOE_CHUNKS; }
        if (i >= 2048) break;
        const int qb = 7 - (i >> 8), j = i & 255;
        if (j < 96) attn_unit(F, a, l, 2, j, qb); else if (j < 160) attn_unit(F, a, l, 0, j - 96, qb); else attn_unit(F, a, l, 1, j - 160, qb);
    }
}

constexpr int PH_LAYER0 = 2, PH_STRIDE = 20, N_PHASES = PH_LAYER0 + PH_STRIDE * DEPTH;
DI pg8::Job mkjob(const bf16* A, const bf16* Bt, int lda, int ldb, int K, int nM, int nN, int epi, bf16* O, int ldc) {
    pg8::Job J; J.A = A; J.Bt = Bt; J.lda = lda; J.ldb = ldb; J.K = K; J.nM = nM; J.nN = nN; J.sched = pg8::SCH_STATIC; J.rot = 0; J.epi = epi; J.O = O; J.ldc = ldc; J.row_limit = 0x7fffffff; J.split_cols = 0; J.split_stride = 0;
    J.cs = nullptr; J.glist = nullptr; J.gather = 0; J.tile0 = 0; J.bexp_rows = 0; return J;
}
DI bool phase_active(int p) {
    if (p < PH_LAYER0) return true;
    const int l = (p - PH_LAYER0) / PH_STRIDE, r = (p - PH_LAYER0) % PH_STRIDE;
    if (r <= 5 || r == 16) return true;
    if (r <= 7) return true;
    return (l & 1) && r < 6 + 2 * MOE_MAX_CHUNKS;
}
DI int phase_njobs(int p) {
    if (p < PH_LAYER0) return 0;
    const int l = (p - PH_LAYER0) / PH_STRIDE, r = (p - PH_LAYER0) % PH_STRIDE;
    if (r == 0) return 2; if (r == 2) return 3; if (r == 4) return 1;
    if (r >= 6 && r < 16) return 1;
    (void)l; return 0;
}
DI bool get_job(Frame& F, const LAS int* mm, int p, int jj, pg8::Job& J) {
    unsigned char* ws = F.ws; const bf16* HB = (const bf16*)(ws + WS_HB);
    const int l = (p - PH_LAYER0) / PH_STRIDE, r = (p - PH_LAYER0) % PH_STRIDE;
    if (r == 0) {
        if (jj == 0) { J = mkjob(HB, (const bf16*)(ws + WS_WIN) + (size_t)l * 2048 * 1024, 1024, 1024, 1024, NTOK / 256, 8, pg8::EPI_STORE, (bf16*)(ws + WS_P1), 1024); J.split_cols = 1024; J.split_stride = (long)((WS_P2 - WS_P1) / 2); }
        else { J = mkjob((const bf16*)(ws + WS_WV) + (size_t)l * 768 * 1024, HB, 1024, 1024, 1024, 3, NTOK / 256, pg8::EPI_STORE, (bf16*)(ws + WS_VTAB), NTOK); J.row_limit = 640; J.rot = 128; }
        return true; }
    if (r == 2) {
        if (jj == 0) { J = mkjob((const bf16*)(ws + WS_CQN), (const bf16*)(ws + WS_WUQ) + (size_t)l * 768 * 256, 256, 256, 256, NTOK / 256, 3, pg8::EPI_ROPEQ, (bf16*)(ws + WS_QC), 576); J.cs = (const float*)(ws + WS_CS); }
        else if (jj == 1) { J = mkjob((const bf16*)(ws + WS_CKVN), (const bf16*)(ws + WS_WUKK) + (size_t)l * 512 * 128, 128, 128, 128, NTOK / 256, 2, pg8::EPI_KNOPE, (bf16*)(ws + WS_KC), 576); J.rot = 128; }
        else { J = mkjob((const bf16*)(ws + WS_WUKV) + (size_t)l * 512 * 128, (const bf16*)(ws + WS_CKVN), 128, 128, 128, 2, NTOK / 256, pg8::EPI_STORE, (bf16*)(ws + WS_VTC), NTOK); J.row_limit = 384; }
        return true; }
    if (r == 4) { J = mkjob(HB, (const bf16*)(ws + WS_WOUT) + (size_t)l * D * D, 1024, 1024, 1024, NTOK / 256, 4, pg8::EPI_STORE, (bf16*)(ws + WS_Y), 1024); return true; }
    if (!(l & 1)) {
#if DENSE_FP8 == 2
        if (r == 6) { J = mkjob((const bf16*)(ws + WS_H8), (const bf16*)(ws + WS_WGUD), 1024, 1024, 1024, NTOK / 256, 28, pg8::EPI_SWIGLU, (bf16*)(ws + WS_ACT), DFF); J.gather = 8; }
        else J = mkjob((const bf16*)(ws + WS_ACT), (const bf16*)(ws + WS_WDD), DFF, DFF, DFF, NTOK / 256, 4, pg8::EPI_STORE, (bf16*)(ws + WS_Y2), 1024);
#elif DENSE_FP8
        if (r == 6) J = mkjob((const bf16*)(ws + WS_H8), (const bf16*)(ws + WS_WGUD), 1024, 1024, 1024, NTOK / 256, 28, pg8::EPI_SWIGLU8, (bf16*)(ws + WS_ACT), DFF);
        else { J = mkjob((const bf16*)(ws + WS_ACT), (const bf16*)(ws + WS_WDD), DFF, DFF, DFF, NTOK / 256, 4, pg8::EPI_STORE, (bf16*)(ws + WS_Y2), 1024); J.gather = 8; }
#else
        if (r == 6) J = mkjob(HB, (const bf16*)(ws + WS_WGUD), 1024, 1024, 1024, NTOK / 256, 28, pg8::EPI_SWIGLU, (bf16*)(ws + WS_ACT), DFF);
        else J = mkjob((const bf16*)(ws + WS_ACT), (const bf16*)(ws + WS_WDD), DFF, DFF, DFF, NTOK / 256, 4, pg8::EPI_STORE, (bf16*)(ws + WS_Y2), 1024);
#endif
        return true; }
    const int c = (r - 6) >> 1; const bool up = !((r - 6) & 1);
    __syncthreads();
    if (F.tid < 8) { LAS int* mw = (LAS int*)mm;
        const int cnt = (int)__hip_atomic_load((unsigned*)(F.ctl + CW_MOECNT + F.tid), __ATOMIC_RELAXED, __HIP_MEMORY_SCOPE_AGENT);
        const int tiles = (cnt + 255) >> 8; int incl = tiles;
#pragma unroll
        for (int o = 1; o < 8; o <<= 1) { const int t = __builtin_amdgcn_ds_bpermute((F.tid - o) << 2, incl); if (F.tid >= o) incl += t; }
        mw[F.tid] = incl - tiles; mw[9 + F.tid] = cnt; if (F.tid == 7) mw[8] = incl; }
    __syncthreads();
    const int total = mm[8]; const int t0 = c * MOE_CHUNK_TILES; int nt = total - t0; if (nt > MOE_CHUNK_TILES) nt = MOE_CHUNK_TILES;
    if (nt <= 0) return false;
    if (up) { J = mkjob((const bf16*)(ws + WS_H8), (const bf16*)(ws + WS_WGUE), 1024, 1024, 1024, nt, 28, pg8::EPI_SWIGLU8, (bf16*)(ws + WS_ACT), DFF); J.gather = 1; J.bexp_rows = 7168; }
    else { J = mkjob((const bf16*)(ws + WS_ACT), (const bf16*)(ws + WS_WDE), DFF, DFF, DFF, nt, 4, pg8::EPI_SCATTER, (bf16*)(ws + WS_YM), 1024); J.bexp_rows = 1024; J.cs = (const float*)(ws + WS_DC); }
    J.sched = pg8::SCH_MOE; J.glist = (const int*)(ws + WS_LIST); J.tile0 = t0;
    return true;
}
#ifndef DBG_MASK
#define DBG_MASK 0xffff
#endif
#define DBG_ON(k) ((DBG_MASK >> (k)) & 1)
template <int KIND> DI void run_phase(Frame& F, KArgs a, int p, int rep, const XcdBarrier& bar, int wave0) {
    LAS int* mm = (LAS int*)(F.lds + MISC_OFF + 512);
    const int nj = phase_njobs(p);
    if constexpr (KIND == -1) { if (p >= PH_LAYER0 && (p - PH_LAYER0) % PH_STRIDE == 2) { RELANE(F); mlstm_state_phase(F); } }
    if (nj > 0) {
        if constexpr (KIND == -1 || KIND >= 10) {
            for (int jj = 0; jj < nj; ++jj) { pg8::Job J; RELANE(F);
                if (get_job(F, mm, p, jj, J)) {
                if (J.epi == pg8::EPI_STORE) { if (J.gather == 8) { if constexpr (DENSE_FP8 == 1 && (KIND == -1 || KIND == 16)) pg8::gemm_phase<pg8::EPI_STORE, false, true>(F.lds, mm, J, F.G, (int)blockIdx.x, F.wave);     }
                                               else { if constexpr (KIND == -1 || KIND == 10) pg8::gemm_phase<pg8::EPI_STORE, false>(F.lds, mm, J, F.G, (int)blockIdx.x, F.wave);     } }
                else if (J.epi == pg8::EPI_ROPEQ) { if constexpr (KIND == -1 || KIND == 11) pg8::gemm_phase<pg8::EPI_ROPEQ, false>(F.lds, mm, J, F.G, (int)blockIdx.x, F.wave);     }
                else if (J.epi == pg8::EPI_KNOPE) { if constexpr (KIND == -1 || KIND == 12) pg8::gemm_phase<pg8::EPI_KNOPE, false>(F.lds, mm, J, F.G, (int)blockIdx.x, F.wave);     }
                else if (J.epi == pg8::EPI_SWIGLU8) { if (J.sched == pg8::SCH_MOE) { if constexpr (KIND == -1 || KIND == 14) pg8::gemm_phase<pg8::EPI_SWIGLU8, true, true>(F.lds, mm, J, F.G, (int)blockIdx.x, F.wave);     }
                                                      else { if constexpr (DENSE_FP8 == 1 && (KIND == -1 || KIND == 13)) pg8::gemm_phase<pg8::EPI_SWIGLU8, false, true>(F.lds, mm, J, F.G, (int)blockIdx.x, F.wave);     } }
                else if (J.epi == pg8::EPI_SWIGLU && J.gather == 8) { if constexpr (DENSE_FP8 == 2 && (KIND == -1 || KIND == 13)) pg8::gemm_phase<pg8::EPI_SWIGLU, false, true>(F.lds, mm, J, F.G, (int)blockIdx.x, F.wave); }
                else if (J.epi == pg8::EPI_SWIGLU) { if constexpr (!DENSE_FP8 && (KIND == -1 || KIND == 13)) pg8::gemm_phase<pg8::EPI_SWIGLU, false>(F.lds, mm, J, F.G, (int)blockIdx.x, F.wave);     }
                else { if constexpr (KIND == -1 || KIND == 15) pg8::gemm_phase<pg8::EPI_SCATTER, true, true>(F.lds, mm, J, F.G, (int)blockIdx.x, F.wave);     } } } }
        if constexpr (KIND == -1) { if (p == PH_LAYER0 && F.G == 256 && (int)blockIdx.x < 128) {
            RELANE(F); __syncthreads(); tr_run(F, a, TR_N_SMALL + (int)blockIdx.x * NWAVES + F.wave, TR_N_EARLY, 128 * NWAVES, (LAS float*)(F.lds + F.wave * 16384)); } }
        return; }
    if (p == 0) { if constexpr (KIND == -1 || KIND == 0) { RELANE(F); p0_prologue(F, a); } return; }
    if (p == 1) { if constexpr (KIND == -1 || KIND == 1) { RELANE(F); phase_row0(F, a); } return; }
    const int l = (p - PH_LAYER0) / PH_STRIDE, r = (p - PH_LAYER0) % PH_STRIDE;
    if (r == 1) { if constexpr (KIND == -1 || KIND == 2) { RELANE(F); phase_fix(F, a, l);
        } }
    else if (r == 3) { if constexpr (KIND == -1 || KIND == 3) { RELANE(F); phase_attn(F, a, l, rep); } }
    else if (r == 5) { if constexpr (KIND == -1 || KIND == 4) { RELANE(F); phase_row1(F, a, l); } }
    else if (r == 16) { if constexpr (KIND == -1 || KIND == 5) { RELANE(F); phase_row2(F, a, l); } }
}

template <int KIND> __global__ void __launch_bounds__(NTHR, 2) mk_fwd(Args args) {
    extern __shared__ __attribute__((aligned(16))) unsigned char lds[];
    KArgs ka = (KArgs)__builtin_amdgcn_kernarg_segment_ptr();
    Frame F;
    F.lds = (LAS unsigned char*)lds; F.MISC = (volatile LAS unsigned*)(F.lds + MISC_OFF);
    F.tid = threadIdx.x; F.lane = F.tid & 63; F.wave = __builtin_amdgcn_readfirstlane(F.tid >> 6);
    F.G = gridDim.x; { const int bx = blockIdx.x; F.cu = (F.G % 8 == 0) ? (bx % 8) * (F.G / 8) + bx / 8 : bx; }
    F.ws = ka->ws; F.out = ka->out; F.ctl = (gu32*)(F.ws + WS_CTL);
    for (int u = F.tid; u < (LDS_BYTES - MISC_OFF) / 4; u += NTHR) ((LAS unsigned*)(F.lds + MISC_OFF))[u] = 0u;
    __syncthreads();
    if constexpr (KIND == -1) {
        XcdBarrier bar = xcd_barrier_post((unsigned*)(F.ctl + CW_BAR), F.MISC + 8, F.tid == 0);
        const int wave0 = F.wave;
        const int lo = ka->ph_lo, hi = ka->ph_hi;
        for (int p = lo; p < hi; ++p) {
            if (!phase_active(p)) continue;
            { int wv = wave0; asm volatile("" : "+s"(wv)); F.wave = wv; RELANE(F);
              KArgs k2 = ka; asm volatile("" : "+s"(k2)); F.ws = k2->ws; F.out = k2->out; F.ctl = (gu32*)(F.ws + WS_CTL);
              run_phase<-1>(F, k2, p, 0, bar, wave0); }
            xcd_barrier(bar, wave0);
#ifdef EXTRA_BAR
            xcd_barrier(bar, wave0);
#endif
#ifdef REP_MASK
            { const int r_ = (p - PH_LAYER0) % PH_STRIDE, l_ = (p - PH_LAYER0) / PH_STRIDE; int cls = -1;
              if (p == 0) cls = 0; else if (p >= PH_LAYER0) { if (r_ == 0) cls = 1; else if (r_ == 1) cls = 2; else if (r_ == 2) cls = 3; else if (r_ == 3) cls = 4; else if (r_ == 4) cls = 5;
                  else if (r_ >= 6 && r_ < 16) cls = (l_ & 1) ? 7 : 6; }
              if (cls >= 0 && ((REP_MASK >> cls) & 1)) { KArgs k3 = ka; asm volatile("" : "+s"(k3)); run_phase<-1>(F, k3, p, 1, bar, wave0); xcd_barrier(bar, wave0); } }
#endif
        }
    } else {
        { XcdBarrier nb; nb.bar = nullptr; nb.x = 0; nb.st = nullptr; run_phase<KIND>(F, ka, ka->ph_lo, 0, nb, 0); }
    }
    (void)args;
}
#if MK_SINGLE
#define MK_KERNELS(X) X(-1)
#else
#define MK_KERNELS(X) X(0) X(1) X(2) X(3) X(4) X(5) X(10) X(11) X(12) X(13) X(14) X(15)
#endif
static int phase_kinds(int p, int* kinds) {
    if (p == 0) { kinds[0] = 0; return 1; } if (p == 1) { kinds[0] = 1; return 1; }
    const int l = (p - PH_LAYER0) / PH_STRIDE, r = (p - PH_LAYER0) % PH_STRIDE;
    if (r == 0) { kinds[0] = 10; return 1; } if (r == 1) { kinds[0] = 2; return 1; } if (r == 2) { kinds[0] = 11; kinds[1] = 12; kinds[2] = 10; return 3; }
    if (r == 3) { kinds[0] = 3; return 1; } if (r == 4) { kinds[0] = 10; return 1; } if (r == 5) { kinds[0] = 4; return 1; } if (r == 16) { kinds[0] = 5; return 1; }
    if (!(l & 1)) { if (r == 6) { kinds[0] = 13; return 1; } if (r == 7) { kinds[0] = 10; return 1; } return 0; }
    if (r >= 6 && r < 16) { kinds[0] = ((r - 6) & 1) ? 15 : 14; return 1; }
    return 0;
}
template <int KIND> static void launch_kind(int grid, hipStream_t stream, const Args& a) { hipLaunchKernelGGL(mk_fwd<KIND>, dim3(grid), dim3(NTHR), LDS_BYTES, stream, a); }
template <int KIND> static bool set_attr() { return hipFuncSetAttribute((const void*)mk_fwd<KIND>, hipFuncAttributeMaxDynamicSharedMemorySize, LDS_BYTES) == hipSuccess; }

extern "C" void kernel_launch(void* const* d_in, const int* in_sizes, int n_in, void* d_out, int out_size, void* d_ws, size_t ws_size, hipStream_t stream) {
    static int grid = 0;
    if (grid == 0) {
        if (n_in != 30 || out_size != NTOK * D || ws_size < WS_END) { fprintf(stderr, "kernel_launch: unexpected shapes (n_in %d out %d ws %zu)\n", n_in, out_size, ws_size); grid = -1; return; }
        int dev = 0, cus = 0;
        if (hipGetDevice(&dev) != hipSuccess || hipDeviceGetAttribute(&cus, hipDeviceAttributeMultiprocessorCount, dev) != hipSuccess) { grid = -1; return; }
        bool ok = true;
#define X(k) ok = ok && set_attr<k>();
        MK_KERNELS(X)
#undef X
        if (!ok) { fprintf(stderr, "kernel_launch: hipFuncSetAttribute failed\n"); grid = -1; return; }
        (void)hipGetLastError();
        grid = cus;
    }
    if (grid < 0) return;
    (void)hipMemsetAsync((char*)d_ws + WS_CTL, 0, CTL_ZERO_BYTES, stream);
    Args a{};
    for (int i = 0; i < 30; ++i) a.in[i] = d_in[i];
    a.out = (float*)d_out; a.ws = (unsigned char*)d_ws;
#if MK_SINGLE
    a.ph_lo = 0; a.ph_hi = N_PHASES;
    launch_kind<-1>(grid, stream, a);
#else
    for (int p = 0; p < N_PHASES; ++p) {
        int kinds[4]; const int nk = phase_kinds(p, kinds);
        a.ph_lo = p; a.ph_hi = p + 1;
        for (int i = 0; i < nk; ++i) {
            switch (kinds[i]) {
#define X(k) case k: launch_kind<k>(grid, stream, a); break;
                MK_KERNELS(X)
#undef X
            }
        }
    }
#endif
}
```
